# Optimizing an MI355X kernel written in HIP

```python
import jax, jax.numpy as jnp
from jax import lax
import numpy as np

D_MODEL = 1024
BATCH = 8
SEQ = 4096
DEPTH = 1
DEC_BATCH = 32
DEC_SEQ = 64
PAST_LEN = 1024

CHUNK = 64
D_MIX = 2 * D_MODEL
D_A = D_MIX // 2
GMLP_HEADS = 8
GMLP_HEAD_DIM = D_A // GMLP_HEADS
GMLP_CHUNK = 128
D_B = D_MIX - D_A
SSM_HEAD_DIM = 64
SSM_HEADS = D_B // SSM_HEAD_DIM
SSM_GROUPS = 2
SSM_STATE = 128
GN = SSM_GROUPS * SSM_STATE
CONV_W = 4
CONV_DIM = D_B + 2 * GN
SSD_CHUNK = CHUNK
D_IN_PROJ = 3 * D_A + D_B + CONV_DIM + SSM_HEADS
SPLITS = (D_A, 2 * D_A, 3 * D_A, 3 * D_A + D_B, 3 * D_A + D_B + CONV_DIM)
EPS = 1e-5

kernel_name = "hybrid_gmlp_ssd_streaming_step"


def rms_norm(x, w):
    xf = x.astype(jnp.float32)
    y = xf * lax.rsqrt(jnp.mean(xf * xf, axis=-1, keepdims=True) + EPS)
    return y.astype(x.dtype) * w


def layer_norm(x, w, b):
    xf = x.astype(jnp.float32)
    mu = jnp.mean(xf, axis=-1, keepdims=True)
    var = jnp.mean(jnp.square(xf - mu), axis=-1, keepdims=True)
    return ((xf - mu) * lax.rsqrt(var + EPS)).astype(x.dtype) * w + b


def gmlp_branch(u, v, g, ln_w, ln_b, ws, bs, chunk_len):
    bsz, seqlen, _ = u.shape
    n_chunks = seqlen // chunk_len
    vn = layer_norm(v, ln_w, ln_b)
    blk = jnp.arange(GMLP_CHUNK) // CHUNK
    mask = (blk[None, :] <= blk[:, None])[:chunk_len, :chunk_len]
    w_mask = jnp.where(mask[None], ws[:, :chunk_len, :chunk_len], 0.0)
    vr = vn.reshape(bsz, n_chunks, chunk_len, GMLP_HEADS, GMLP_HEAD_DIM)
    mixed = jnp.einsum('hts,bcshd->bcthd', w_mask, vr) + bs[:, :chunk_len].T[:, :, None]
    ur = u.reshape(bsz, n_chunks, chunk_len, GMLP_HEADS, GMLP_HEAD_DIM)
    out = (ur * mixed).reshape(bsz, seqlen, D_A) * jax.nn.silu(g)
    return out, vn


def causal_conv(xbc, conv_state, w, b):
    seqlen = xbc.shape[1]
    xpad = jnp.concatenate([conv_state, xbc], axis=1)
    y = xpad[:, 0:seqlen] * w[0]
    for k in range(1, CONV_W):
        y = y + xpad[:, k:k + seqlen] * w[k]
    return jax.nn.silu(y + b), xpad[:, -(CONV_W - 1):]


def ssd_scan(x, dt, a, bm, cm, h0, chunk):
    bsz, seqlen, n_heads, hd = x.shape
    nc = seqlen // chunk
    e = n_heads // SSM_GROUPS
    x = x.reshape(bsz, nc, chunk, SSM_GROUPS, e, hd)
    dt = dt.reshape(bsz, nc, chunk, SSM_GROUPS, e)
    bm = bm.reshape(bsz, nc, chunk, SSM_GROUPS, SSM_STATE)
    cm = cm.reshape(bsz, nc, chunk, SSM_GROUPS, SSM_STATE)
    a_cum = jnp.cumsum(dt.astype(jnp.float32) * a.reshape(SSM_GROUPS, e).astype(jnp.float32), axis=2)
    seg = a_cum[:, :, :, None] - a_cum[:, :, None]
    causal = jnp.tril(jnp.ones((chunk, chunk), dtype=bool))[:, :, None, None]
    l_dec = jnp.exp(jnp.where(causal, seg, -jnp.inf)).astype(x.dtype)
    xdt = x * dt[..., None]
    cb = jnp.einsum('bclgn,bcsgn->bclsg', cm, bm)
    y_diag = jnp.einsum('bclsg,bclsge,bcsgep->bclgep', cb, l_dec, xdt)
    decay_to_end = jnp.exp(a_cum[:, :, -1:] - a_cum).astype(x.dtype)
    states = jnp.einsum('bclgn,bclge,bclgep->bcgepn', bm, decay_to_end, xdt)
    chunk_decay = jnp.exp(a_cum[:, :, -1]).astype(x.dtype)

    def step(h, inp):
        s, d = inp
        return h * d[..., None, None] + s, h

    h_init = h0.reshape(bsz, SSM_GROUPS, e, hd, SSM_STATE)
    h_last, h_in = lax.scan(step, h_init, (jnp.moveaxis(states, 1, 0), jnp.moveaxis(chunk_decay, 1, 0)))
    h_in = jnp.moveaxis(h_in, 0, 1)
    y_off = jnp.einsum('bclgn,bcgepn,bclge->bclgep', cm, h_in, jnp.exp(a_cum).astype(x.dtype))
    y = (y_diag + y_off).reshape(bsz, seqlen, n_heads, hd)
    return y, h_last.reshape(bsz, n_heads, hd, SSM_STATE)


def mamba_branch(z, xbc, dt_raw, conv_state, h0, conv_w, conv_b, dt_bias, a_log, d_skip, norm_w, chunk):
    bsz, seqlen, _ = z.shape
    xbc, new_conv = causal_conv(xbc, conv_state, conv_w, conv_b)
    xs = xbc[..., :D_B].reshape(bsz, seqlen, SSM_HEADS, SSM_HEAD_DIM)
    bm = xbc[..., D_B:D_B + GN].reshape(bsz, seqlen, SSM_GROUPS, SSM_STATE)
    cm = xbc[..., D_B + GN:].reshape(bsz, seqlen, SSM_GROUPS, SSM_STATE)
    dt = jax.nn.softplus(dt_raw + dt_bias)
    a = -jnp.exp(a_log)
    y, h_last = ssd_scan(xs, dt, a, bm, cm, h0, chunk)
    y = (y + xs * d_skip[:, None]).reshape(bsz, seqlen, D_B)
    y = rms_norm(y * jax.nn.silu(z), norm_w)
    return y, h_last, new_conv


def mixer_layer(x, conv_state, h0, gmlp_chunk, ssd_chunk, norm_in_w, w_in, gmlp_ln_w, gmlp_ln_b,
                gmlp_ws, gmlp_bs, conv_w, conv_b, dt_bias, a_log, d_skip, ssm_norm_w, w_out):
    h = rms_norm(x, norm_in_w) @ w_in
    u, v, g, z, xbc, dt_raw = jnp.split(h, SPLITS, axis=-1)
    a_out, vn = gmlp_branch(u, v, g, gmlp_ln_w, gmlp_ln_b, gmlp_ws, gmlp_bs, gmlp_chunk)
    b_out, h_last, new_conv = mamba_branch(z, xbc, dt_raw, conv_state, h0, conv_w, conv_b,
                                           dt_bias, a_log, d_skip, ssm_norm_w, ssd_chunk)
    y = x + jnp.concatenate([a_out, b_out], axis=-1) @ w_out
    return y, vn, h_last, new_conv


def setup_inputs(seed: int = 0) -> dict:
    key = jax.random.key(seed)
    ks = jax.random.split(key, 20)
    nrm = jax.random.normal
    dt0 = jnp.exp(jax.random.uniform(ks[12], (DEPTH, SSM_HEADS)) * (np.log(0.1) - np.log(0.001)) + np.log(0.001))
    return {
        "x_prompt": nrm(ks[0], (BATCH, SEQ, D_MODEL), jnp.float32),
        "x_sample": nrm(ks[1], (DEC_BATCH, DEC_SEQ, D_MODEL), jnp.float32),
        "state_ssm": 0.1 * nrm(ks[2], (DEPTH, DEC_BATCH, SSM_HEADS, SSM_HEAD_DIM, SSM_STATE), jnp.float32),
        "state_conv": nrm(ks[3], (DEPTH, DEC_BATCH, CONV_W - 1, CONV_DIM), jnp.float32),
        "norm_in_w": 1.0 + 0.02 * nrm(ks[4], (DEPTH, D_MODEL), jnp.float32),
        "w_in": nrm(ks[5], (DEPTH, D_MODEL, D_IN_PROJ), jnp.float32) * D_MODEL ** -0.5,
        "gmlp_ln_w": 1.0 + 0.02 * nrm(ks[6], (DEPTH, D_A), jnp.float32),
        "gmlp_ln_b": 0.02 * nrm(ks[7], (DEPTH, D_A), jnp.float32),
        "gmlp_ws": nrm(ks[8], (DEPTH, GMLP_HEADS, GMLP_CHUNK, GMLP_CHUNK), jnp.float32) * GMLP_CHUNK ** -0.5,
        "gmlp_bs": 1.0 + 0.02 * nrm(ks[9], (DEPTH, GMLP_HEADS, GMLP_CHUNK), jnp.float32),
        "conv_w": nrm(ks[10], (DEPTH, CONV_W, CONV_DIM), jnp.float32) * CONV_W ** -0.5,
        "conv_b": 0.02 * nrm(ks[11], (DEPTH, CONV_DIM), jnp.float32),
        "dt_bias": dt0 + jnp.log(-jnp.expm1(-dt0)),
        "a_log": jnp.log(jax.random.uniform(ks[13], (DEPTH, SSM_HEADS), minval=1.0, maxval=16.0)),
        "d_skip": 1.0 + 0.02 * nrm(ks[14], (DEPTH, SSM_HEADS), jnp.float32),
        "ssm_norm_w": 1.0 + 0.02 * nrm(ks[15], (DEPTH, D_B), jnp.float32),
        "w_out": nrm(ks[16], (DEPTH, D_MIX, D_MODEL), jnp.float32) * D_MIX ** -0.5,
        "norm_f_w": 1.0 + 0.02 * nrm(ks[17], (D_MODEL,), jnp.float32),
    }


def reference(x_prompt, x_sample, state_ssm, state_conv, norm_in_w, w_in, gmlp_ln_w, gmlp_ln_b,
              gmlp_ws, gmlp_bs, conv_w, conv_b, dt_bias, a_log, d_skip, ssm_norm_w, w_out, norm_f_w):
    yp, ys = x_prompt, x_sample
    bp, dec_len = yp.shape[0], ys.shape[1]
    ssm_p, conv_p, ssm_s, conv_s, v_s = [], [], [], [], []
    for i in range(DEPTH):
        lw = (norm_in_w[i], w_in[i], gmlp_ln_w[i], gmlp_ln_b[i], gmlp_ws[i], gmlp_bs[i], conv_w[i],
              conv_b[i], dt_bias[i], a_log[i], d_skip[i], ssm_norm_w[i], w_out[i])
        conv0 = jnp.zeros((bp, CONV_W - 1, CONV_DIM), yp.dtype)
        h0 = jnp.zeros((bp, SSM_HEADS, SSM_HEAD_DIM, SSM_STATE), yp.dtype)
        yp, _, hp, cp = mixer_layer(yp, conv0, h0, GMLP_CHUNK, SSD_CHUNK, *lw)
        ys, vs, hs, cs = mixer_layer(ys, state_conv[i], state_ssm[i], dec_len, dec_len, *lw)
        ssm_p.append(hp)
        conv_p.append(cp)
        ssm_s.append(hs)
        conv_s.append(cs)
        v_s.append(vs)
    y_prompt = rms_norm(yp, norm_f_w)
    y_sample = rms_norm(ys, norm_f_w)
    return (y_prompt, y_sample, jnp.stack(ssm_p), jnp.stack(conv_p), jnp.stack(ssm_s), jnp.stack(conv_s), jnp.stack(v_s))
```

```cpp
#include <hip/hip_runtime.h>
#include <hip/hip_cooperative_groups.h>
#include <cstdio>
namespace cg = cooperative_groups;

#ifndef ONE_LAUNCH
#define ONE_LAUNCH 1
#endif

#define LAS __attribute__((address_space(3)))
typedef unsigned short bf16_t;
typedef short bf16x8 __attribute__((ext_vector_type(8)));
typedef float f32x4 __attribute__((ext_vector_type(4)));
typedef float f32x2 __attribute__((ext_vector_type(2)));
typedef unsigned u32x4 __attribute__((ext_vector_type(4)));
typedef unsigned u32x2 __attribute__((ext_vector_type(2)));

constexpr int T_ALL = 34816, T_PROMPT = 32768, DM = 1024, HS = 5632  , DIN = 5648;
constexpr int XS = 1536;
constexpr float EPS = 1e-5f;
constexpr int LDS_BYTES = 131072 + 1024;
constexpr int LDS_ITEM_OFF = 131072;

constexpr size_t O_Y = 0, O_SSMP = 35651584, O_CONVP = 36700160, O_SSMS = 36737024, O_CONVS = 40931328, O_VS = 41078784;

struct Params {
    const float* x_prompt; const float* x_sample; const float* state_ssm; const float* state_conv;
    const float* norm_in_w; const float* w_in; const float* ln_w; const float* ln_b; const float* gws; const float* gbs;
    const float* conv_w; const float* conv_b; const float* dt_bias; const float* a_log; const float* d_skip; const float* ssm_norm_w;
    const float* w_out; const float* norm_f_w;
    float* out;
    bf16_t* h; bf16_t* xn; bf16_t* WinT; bf16_t* WoutT; bf16_t* WdtT; bf16_t* Wm; bf16_t* BT; bf16_t* xbc;
    float* stats; float* ssq; float* fpart; float* dtT; float* acT; unsigned* ctr;
};

constexpr size_t WS_H = 0;
constexpr size_t WS_XN = WS_H + (size_t)T_ALL * HS * 2;
constexpr size_t WS_WINT = WS_XN + (size_t)T_ALL * DM * 2;
constexpr size_t WS_WOUTT = WS_WINT + (size_t)5632 * 1024 * 2;
constexpr size_t WS_WDTT = WS_WOUTT + (size_t)1024 * 2048 * 2;
constexpr size_t WS_WM = WS_WDTT + (size_t)16 * 1024 * 2;
constexpr size_t WS_BT = WS_WM + (size_t)8 * 128 * 128 * 2;
constexpr size_t WS_STATS = WS_BT + (size_t)544 * 2 * 128 * 64 * 2;
constexpr size_t WS_SSQ = WS_STATS + (size_t)T_ALL * 32 * 4;
constexpr size_t WS_FPART = WS_SSQ + (size_t)T_ALL * 4;
constexpr size_t WS_DTT = WS_FPART + (size_t)T_ALL * 16 * 4;
constexpr size_t WS_ACT = WS_DTT + (size_t)T_ALL * 16 * 4;
constexpr size_t WS_CTR = WS_ACT + (size_t)T_ALL * 16 * 4;
constexpr size_t WS_END = WS_CTR + 1024;

__device__ __forceinline__ unsigned cvt_pk_bf16(float lo, float hi) { unsigned r; asm("v_cvt_pk_bf16_f32 %0, %1, %2" : "=v"(r) : "v"(lo), "v"(hi)); return r; }
__device__ __forceinline__ float bf_lo(unsigned w) { return __uint_as_float(w << 16); }
__device__ __forceinline__ float bf_hi(unsigned w) { return __uint_as_float(w & 0xffff0000u); }
__device__ __forceinline__ float silu_f(float x) { return x * __builtin_amdgcn_rcpf(1.f + __expf(-x)); }
__device__ __forceinline__ const float* xrow_ptr(const Params& p, int row) {
    return row < T_PROMPT ? p.x_prompt + (size_t)row * DM : p.x_sample + (size_t)(row - T_PROMPT) * DM;
}
#define MFMA16(a, b, c) __builtin_amdgcn_mfma_f32_16x16x32_bf16((a), (b), (c), 0, 0, 0)

__device__ __forceinline__ void transpose_tile(const float* __restrict__ src, int ldn, int k0, int n0, const float* __restrict__ scale, int s0,
                                               bf16_t* __restrict__ dst, int ldk, int kd0, LAS float* tl) {
    const int tid = threadIdx.x;
    __syncthreads();
    {
        const int r = tid >> 4, c4 = tid & 15;
#pragma unroll
        for (int i = 0; i < 2; ++i) {
            const int k = r + 32 * i;
            f32x4 v = *(const f32x4*)(src + (size_t)(k0 + k) * ldn + n0 + c4 * 4);
            const float sc = scale ? scale[s0 + k] : 1.f;
            tl[k * 65 + c4 * 4 + 0] = v[0] * sc; tl[k * 65 + c4 * 4 + 1] = v[1] * sc; tl[k * 65 + c4 * 4 + 2] = v[2] * sc; tl[k * 65 + c4 * 4 + 3] = v[3] * sc;
        }
    }
    __syncthreads();
    {
        const int n = tid >> 3, kg = tid & 7;
        float f[8];
#pragma unroll
        for (int j = 0; j < 8; ++j) f[j] = tl[(kg * 8 + j) * 65 + n];
        u32x4 w; w.x = cvt_pk_bf16(f[0], f[1]); w.y = cvt_pk_bf16(f[2], f[3]); w.z = cvt_pk_bf16(f[4], f[5]); w.w = cvt_pk_bf16(f[6], f[7]);
        *(u32x4*)(dst + (size_t)(n0 + n) * ldk + kd0 + kg * 8) = w;
    }
}

__device__ __forceinline__ void phase0(const Params& p, LAS unsigned char* lds) {
    const int tid = threadIdx.x, lane = tid & 63, wid = tid >> 6;
    const int G = gridDim.x, blk = blockIdx.x;
    for (int i = blk * 512 + tid; i < T_ALL; i += G * 512) p.ssq[i] = 0.f;
    if (blk == 0 && tid < 64) p.ctr[tid] = 0u;
    for (int i = blk * 512 + tid; i < 16 * 1024; i += G * 512) {
        const int j = i >> 10, k = i & 1023;
        p.WdtT[i] = (bf16_t)(cvt_pk_bf16(p.w_in[(size_t)k * DIN + 5632 + j] * p.norm_in_w[k], 0.f) & 0xffffu);
    }
    for (int i = blk * 512 + tid; i < 8 * 128 * 128; i += G * 512) {
        const int t = (i >> 7) & 127, s = i & 127;
        float v = p.gws[i]; if ((s >> 6) > (t >> 6)) v = 0.f;
        p.Wm[i] = (bf16_t)(cvt_pk_bf16(v, 0.f) & 0xffffu);
    }
    LAS float* tl = (LAS float*)lds;
    for (int ti = blk; ti < 1920; ti += G) {
        if (ti < 1408) {
            const int kt = ti / 88, nt_ = ti % 88;
            transpose_tile(p.w_in, DIN, kt * 64, nt_ * 64, p.norm_in_w, kt * 64, p.WinT, 1024, kt * 64, tl);
        } else {
            const int t2 = ti - 1408, kt = t2 >> 4, nt_ = t2 & 15;
            const int k0 = kt * 64;
            if (k0 >= 1024) transpose_tile(p.w_out, 1024, k0, nt_ * 64, p.ssm_norm_w, k0 - 1024, p.WoutT, 2048, k0 - 1024, tl);
            else            transpose_tile(p.w_out, 1024, k0, nt_ * 64, nullptr, 0, p.WoutT, 2048, k0 + 1024, tl);
        }
    }
    for (int row = blk * 8 + wid; row < T_ALL; row += G * 8) {
        const float* src = xrow_ptr(p, row);
        f32x4 v[4]; float ss = 0.f;
#pragma unroll
        for (int i = 0; i < 4; ++i) { v[i] = *(const f32x4*)(src + i * 256 + lane * 4); ss += v[i][0] * v[i][0] + v[i][1] * v[i][1] + v[i][2] * v[i][2] + v[i][3] * v[i][3]; }
#pragma unroll
        for (int o = 32; o >= 1; o >>= 1) ss += __shfl_xor(ss, o);
        const float rs = rsqrtf(ss * (1.f / 1024.f) + EPS);
#pragma unroll
        for (int i = 0; i < 4; ++i) {
            u32x2 w; w.x = cvt_pk_bf16(v[i][0] * rs, v[i][1] * rs); w.y = cvt_pk_bf16(v[i][2] * rs, v[i][3] * rs);
            *(u32x2*)(p.xn + (size_t)row * DM + i * 256 + lane * 4) = w;
        }
    }
}

constexpr int BM = 256, BK = 64, HALF = 128, HTB = HALF * BK * 2, NXCD = 8, WGM = 8;
__device__ __forceinline__ int lds_byte(int r, int c) { const int st = (r >> 4) * 2 + (c >> 5), rr = r & 15, cc = c & 31, ob = rr * 64 + cc * 2; return st * 1024 + (ob ^ (((ob >> 9) & 1) << 5)); }
__device__ __forceinline__ void stage_rc(int b, int& R, int& C) { const int st = b / 1024, sb = b % 1024, swz = sb ^ (((sb >> 9) & 1) << 5); R = (st >> 1) * 16 + swz / 64; C = (st & 1) * 32 + (swz % 64) / 2; }
__device__ __forceinline__ int perm32(int rho) { const int n = rho >> 4, i = rho & 15; return 8 * (i >> 2) + 4 * n + (i & 3); }
struct Unit { int pm, pn; };

template <int MODE>
__device__ __forceinline__ bool unit_next(int i, int G, int c, Unit& u) {
    constexpr int nM = 136, nN = (MODE == 1) ? 22 : 4, nwg = nM * nN;
    const long L = (long)i * G + c; if (L >= nwg) return false;
    int wgid = (int)L; { const int q = nwg / NXCD, r = nwg % NXCD, xcd = wgid % NXCD, off = wgid / NXCD; wgid = (xcd < r ? xcd * (q + 1) : r * (q + 1) + (xcd - r) * q) + off; }
    const int nig = WGM * nN, gid = wgid / nig, fm = gid * WGM, gsz = (nM - fm) < WGM ? (nM - fm) : WGM;
    u.pm = fm + ((wgid % nig) % gsz); u.pn = (wgid % nig) / gsz; return true;
}

template <int MODE>
__device__ __forceinline__ void gemm_phase(const Params& p, LAS unsigned char* lds) {
    constexpr int K = (MODE == 1) ? 1024 : 2048;
    constexpr int LDA = (MODE == 1) ? 1024 : HS;
    constexpr bool PERM = (MODE == 1);
    constexpr int nt = K / BK;
    const int tid = threadIdx.x, wid = __builtin_amdgcn_readfirstlane(tid >> 6), lane = tid & 63, wr = wid >> 2, wc = wid & 3, fr = lane & 15, fq = lane >> 4;
    const int G = gridDim.x, cblk = blockIdx.x;
    const char* Abase = (MODE == 1) ? (const char*)p.xn : (const char*)(p.h + 3072);
    const char* Bbase = (MODE == 1) ? (const char*)p.WinT : (const char*)p.WoutT;
    unsigned voffA[2], voffB[2];
#pragma unroll
    for (int i = 0; i < 2; ++i) { int R, C; stage_rc(tid * 16 + i * 8192, R, C); const int Rb = PERM ? ((R & ~31) + perm32(R & 31)) : R;
        voffA[i] = (unsigned)(R * LDA + C) * 2u; voffB[i] = (unsigned)(Rb * K + C) * 2u; }
    constexpr size_t kstep = (size_t)(BK * 2);
    constexpr size_t hstepA = (size_t)HALF * LDA * 2, tstepA = 2 * hstepA;
    constexpr size_t hstepB = (size_t)HALF * K * 2, tstepB = 2 * hstepB;
    const unsigned ldsw = (unsigned)wid * 1024u;
    const int aoff = lds_byte(wr * 64 + fr, fq * 8), boff = lds_byte(wc * 32 + fr, fq * 8);
#define AK(t) ((long)(t) * 128 + ((MODE == 2 && (t) >= 16) ? -8192L : 0L))
#define PG8_SA(b, h) (((b) * 2 + (h)) * HTB)
#define PG8_SB(b, h) ((4 + (b) * 2 + (h)) * HTB)
#define PG8_STAGE(bufoff, gbase, voff) do { _Pragma("unroll") for (int _i = 0; _i < 2; ++_i) \
        __builtin_amdgcn_global_load_lds((const unsigned*)((const char*)(gbase) + (voff)[_i]), (LAS unsigned*)(lds + (bufoff) + ldsw + _i * 8192), 16, 0, 0); } while (0)
#define PG8_LDA(dst, b, h) do { _Pragma("unroll") for (int m = 0; m < 4; ++m) _Pragma("unroll") for (int k = 0; k < 2; ++k) dst[m][k] = *(const LAS bf16x8*)(lds + PG8_SA(b, h) + aoff + m * 2048 + k * 1024); } while (0)
#define PG8_LDB(dst, b, h) do { _Pragma("unroll") for (int n = 0; n < 2; ++n) _Pragma("unroll") for (int k = 0; k < 2; ++k) dst[n][k] = *(const LAS bf16x8*)(lds + PG8_SB(b, h) + boff + n * 2048 + k * 1024); } while (0)
#define PG8_MMA(ai, bj, At, Bt) do { __builtin_amdgcn_s_setprio(1); _Pragma("unroll") for (int m = 0; m < 4; ++m) _Pragma("unroll") for (int n = 0; n < 2; ++n) _Pragma("unroll") for (int k = 0; k < 2; ++k) \
        acc[ai][bj][m][n] = __builtin_amdgcn_mfma_f32_16x16x32_bf16(Bt[n][k], At[m][k], acc[ai][bj][m][n], 0, 0, 0); __builtin_amdgcn_s_setprio(0); } while (0)
#define PG8_WAIT_V(n) asm volatile("s_waitcnt vmcnt(" #n ")" ::: "memory")
#define PG8_WAIT_L(n) asm volatile("s_waitcnt lgkmcnt(" #n ")" ::: "memory")
#define PG8_BAR __builtin_amdgcn_s_barrier()
#define PG8_SCHED __builtin_amdgcn_sched_barrier(0)
    Unit cur, nxt; int ui = 0;
    if (!unit_next<MODE>(0, G, cblk, cur)) return;
    f32x4 acc[2][2][4][2];
#pragma unroll
    for (int a = 0; a < 2; ++a)
#pragma unroll
        for (int b = 0; b < 2; ++b)
#pragma unroll
            for (int m = 0; m < 4; ++m)
#pragma unroll
                for (int n = 0; n < 2; ++n) acc[a][b][m][n] = (f32x4){0.f, 0.f, 0.f, 0.f};
    bf16x8 At[4][2], B0[2][2], B1[2][2];
    const char* cA = Abase + (size_t)cur.pm * tstepA; const char* cB = Bbase + (size_t)cur.pn * tstepB;
    PG8_STAGE(PG8_SB(0, 0), cB, voffB); PG8_STAGE(PG8_SA(0, 0), cA, voffA); PG8_STAGE(PG8_SB(0, 1), cB + hstepB, voffB); PG8_STAGE(PG8_SA(0, 1), cA + hstepA, voffA);
    if (wr == 1) PG8_BAR;
    PG8_WAIT_V(4); PG8_BAR;
    PG8_STAGE(PG8_SB(1, 0), cB + kstep, voffB); PG8_STAGE(PG8_SA(1, 0), cA + kstep, voffA); PG8_STAGE(PG8_SB(1, 1), cB + hstepB + kstep, voffB);
    PG8_WAIT_V(6); PG8_BAR;
    for (;;) {
        const bool has_next = unit_next<MODE>(ui + 1, G, cblk, nxt);
        const char* nA = has_next ? Abase + (size_t)nxt.pm * tstepA : cA; const char* nB = has_next ? Bbase + (size_t)nxt.pn * tstepB : cB;
#pragma unroll 1
        for (int t = 0; t < nt; t += 2) {
            const bool last = (t == nt - 2);
            const char* a1 = cA + AK(t + 1);
            const char* a2 = last ? nA : cA + AK(t + 2); const char* b2 = last ? nB : cB + (size_t)(t + 2) * kstep;
            const char* a3 = last ? nA + kstep : cA + AK(t + 3); const char* b3 = b2 + kstep;
            if (MODE == 2 && t == 16) {
#pragma unroll
                for (int ai = 0; ai < 2; ++ai)
#pragma unroll
                    for (int m = 0; m < 4; ++m) {
                        const int row = cur.pm * BM + ai * HALF + wr * 64 + m * 16 + fr;
                        const float r = rsqrtf(p.ssq[row] * (1.f / 1024.f) + EPS);
#pragma unroll
                        for (int bj = 0; bj < 2; ++bj)
#pragma unroll
                            for (int n = 0; n < 2; ++n) acc[ai][bj][m][n] *= r;
                    }
            }
            PG8_LDB(B0, 0, 0); PG8_SCHED; PG8_LDA(At, 0, 0); PG8_STAGE(PG8_SA(1, 1), a1 + hstepA, voffA);
            PG8_WAIT_L(8); PG8_BAR; PG8_WAIT_L(0); PG8_MMA(0, 0, At, B0); PG8_BAR; PG8_SCHED;
            PG8_LDB(B1, 0, 1); PG8_STAGE(PG8_SB(0, 0), b2, voffB);
            PG8_BAR; PG8_WAIT_L(0); PG8_MMA(0, 1, At, B1); PG8_BAR;
            PG8_LDA(At, 0, 1); PG8_STAGE(PG8_SA(0, 0), a2, voffA);
            PG8_BAR; PG8_WAIT_L(0); PG8_MMA(1, 0, At, B0); PG8_BAR; PG8_SCHED;
            PG8_STAGE(PG8_SB(0, 1), b2 + hstepB, voffB);
            PG8_WAIT_V(6); PG8_BAR; PG8_MMA(1, 1, At, B1); PG8_BAR;
            PG8_LDB(B0, 1, 0); PG8_SCHED; PG8_LDA(At, 1, 0); PG8_STAGE(PG8_SA(0, 1), a2 + hstepA, voffA);
            PG8_WAIT_L(8); PG8_BAR; PG8_WAIT_L(0); PG8_MMA(0, 0, At, B0); PG8_BAR; PG8_SCHED;
            PG8_LDB(B1, 1, 1); PG8_STAGE(PG8_SB(1, 0), b3, voffB);
            PG8_BAR; PG8_WAIT_L(0); PG8_MMA(0, 1, At, B1); PG8_BAR;
            PG8_LDA(At, 1, 1); PG8_STAGE(PG8_SA(1, 0), a3, voffA);
            PG8_BAR; PG8_WAIT_L(0); PG8_MMA(1, 0, At, B0); PG8_BAR; PG8_SCHED;
            PG8_STAGE(PG8_SB(1, 1), b3 + hstepB, voffB);
            PG8_WAIT_V(6); PG8_BAR; PG8_MMA(1, 1, At, B1); PG8_BAR;
        }
        if (MODE == 1) {
            const int row0 = cur.pm * BM + wr * 64 + fr, col0 = cur.pn * BM + wc * 32 + 8 * fq;
            const bool isV = (cur.pn >= 4 && cur.pn < 8);
#pragma unroll
            for (int ai = 0; ai < 2; ++ai)
#pragma unroll
                for (int m = 0; m < 4; ++m) {
                    const int row = row0 + ai * HALF + m * 16;
                    bf16_t* rowp = p.h + (size_t)row * HS + col0;
                    float s = 0.f, ss = 0.f;
#pragma unroll
                    for (int bj = 0; bj < 2; ++bj) {
                        const f32x4 v0 = acc[ai][bj][m][0], v1 = acc[ai][bj][m][1];
                        u32x4 w; w.x = cvt_pk_bf16(v0[0], v0[1]); w.y = cvt_pk_bf16(v0[2], v0[3]); w.z = cvt_pk_bf16(v1[0], v1[1]); w.w = cvt_pk_bf16(v1[2], v1[3]);
                        *(u32x4*)(rowp + bj * HALF) = w;
                        s += (v0[0] + v0[1]) + (v0[2] + v0[3]) + (v1[0] + v1[1]) + (v1[2] + v1[3]);
                        ss += v0[0] * v0[0] + v0[1] * v0[1] + v0[2] * v0[2] + v0[3] * v0[3] + v1[0] * v1[0] + v1[1] * v1[1] + v1[2] * v1[2] + v1[3] * v1[3];
                    }
                    if (isV) {
                        s += __shfl_xor(s, 16); ss += __shfl_xor(ss, 16);
                        s += __shfl_xor(s, 32); ss += __shfl_xor(ss, 32);
                        if (fq == 0) { f32x2 o; o.x = s; o.y = ss; *(f32x2*)(p.stats + ((size_t)row * 16 + (cur.pn - 4) * 4 + wc) * 2) = o; }
                    }
                }
        } else {
            const int row0 = cur.pm * BM + wr * 64 + fr, col0 = cur.pn * BM + wc * 32 + 4 * fq;
#pragma unroll
            for (int ai = 0; ai < 2; ++ai)
#pragma unroll
                for (int m = 0; m < 4; ++m) {
                    const int row = row0 + ai * HALF + m * 16;
                    const float* xr = xrow_ptr(p, row) + col0;
                    float* orow = p.out + (size_t)row * DM + col0;
                    float ss = 0.f;
#pragma unroll
                    for (int bj = 0; bj < 2; ++bj)
#pragma unroll
                        for (int n = 0; n < 2; ++n) {
                            const f32x4 xv = *(const f32x4*)(xr + bj * HALF + n * 16);
                            const f32x4 v = acc[ai][bj][m][n] + xv;
                            *(f32x4*)(orow + bj * HALF + n * 16) = v;
                            ss += v[0] * v[0] + v[1] * v[1] + v[2] * v[2] + v[3] * v[3];
                        }
                    ss += __shfl_xor(ss, 16); ss += __shfl_xor(ss, 32);
                    if (fq == 0) p.fpart[(size_t)row * 16 + cur.pn * 4 + wc] = ss;
                }
        }
        if (!has_next) break;
#pragma unroll
        for (int a = 0; a < 2; ++a)
#pragma unroll
            for (int b = 0; b < 2; ++b)
#pragma unroll
                for (int m = 0; m < 4; ++m)
#pragma unroll
                    for (int n = 0; n < 2; ++n) acc[a][b][m][n] = (f32x4){0.f, 0.f, 0.f, 0.f};
        cur = nxt; cA = nA; cB = nB; ++ui;
    }
    PG8_WAIT_V(0);
    if (wr == 0) PG8_BAR;
    PG8_BAR;
#undef AK
#undef PG8_SA
#undef PG8_SB
#undef PG8_STAGE
#undef PG8_LDA
#undef PG8_LDB
#undef PG8_MMA
#undef PG8_WAIT_V
#undef PG8_WAIT_L
#undef PG8_BAR
#undef PG8_SCHED
}

__device__ __forceinline__ void unpack8(const bf16x8 v, float* f) {
    const u32x4 w = __builtin_bit_cast(u32x4, v);
    f[0] = bf_lo(w.x); f[1] = bf_hi(w.x); f[2] = bf_lo(w.y); f[3] = bf_hi(w.y); f[4] = bf_lo(w.z); f[5] = bf_hi(w.z); f[6] = bf_lo(w.w); f[7] = bf_hi(w.w);
}

__device__ __forceinline__ void conv_sub(const Params& p, int ci, int third) {
    const int tid = threadIdx.x;
    const int u = third * 512 + tid, cg_ = u % 192, rb = u / 192, ch0 = cg_ * 8;
    const int r0 = ci * 64;
    const bool prompt = ci < 512;
    const int c = ci & 63;
    float w0[8], w1[8], w2[8], w3[8], bb[8];
#pragma unroll
    for (int q = 0; q < 2; ++q) {
        const f32x4 a0 = *(const f32x4*)(p.conv_w + 0 * XS + ch0 + q * 4), a1 = *(const f32x4*)(p.conv_w + 1 * XS + ch0 + q * 4);
        const f32x4 a2 = *(const f32x4*)(p.conv_w + 2 * XS + ch0 + q * 4), a3 = *(const f32x4*)(p.conv_w + 3 * XS + ch0 + q * 4);
        const f32x4 b4 = *(const f32x4*)(p.conv_b + ch0 + q * 4);
#pragma unroll
        for (int j = 0; j < 4; ++j) { w0[q * 4 + j] = a0[j]; w1[q * 4 + j] = a1[j]; w2[q * 4 + j] = a2[j]; w3[q * 4 + j] = a3[j]; bb[q * 4 + j] = b4[j]; }
    }
    float x0[8], x1[8], x2[8];
    const bf16_t* hx = p.h + (size_t)r0 * HS + 4096 + ch0;
    if (rb > 0 || (prompt && c != 0)) {
        const int lb = rb * 8;
        unpack8(*(const bf16x8*)(hx + (long)(lb - 3) * HS), x0);
        unpack8(*(const bf16x8*)(hx + (long)(lb - 2) * HS), x1);
        unpack8(*(const bf16x8*)(hx + (long)(lb - 1) * HS), x2);
    } else if (prompt) {
#pragma unroll
        for (int j = 0; j < 8; ++j) { x0[j] = 0.f; x1[j] = 0.f; x2[j] = 0.f; }
    } else {
        const float* sc = p.state_conv + (size_t)(ci - 512) * 3 * XS + ch0;
#pragma unroll
        for (int q = 0; q < 2; ++q) {
            const f32x4 a0 = *(const f32x4*)(sc + 0 * XS + q * 4), a1 = *(const f32x4*)(sc + 1 * XS + q * 4), a2 = *(const f32x4*)(sc + 2 * XS + q * 4);
#pragma unroll
            for (int j = 0; j < 4; ++j) { x0[q * 4 + j] = a0[j]; x1[q * 4 + j] = a1[j]; x2[q * 4 + j] = a2[j]; }
        }
    }
    bf16x8 raw[8];
#pragma unroll
    for (int rr = 0; rr < 8; ++rr) raw[rr] = *(const bf16x8*)(hx + (long)(rb * 8 + rr) * HS);
    unsigned ob[8][4];
#pragma unroll
    for (int rr = 0; rr < 8; ++rr) {
        float cur[8], o[8];
        unpack8(raw[rr], cur);
#pragma unroll
        for (int j = 0; j < 8; ++j) {
            const float y = bb[j] + w0[j] * x0[j] + w1[j] * x1[j] + w2[j] * x2[j] + w3[j] * cur[j];
            o[j] = silu_f(y);
            x0[j] = x1[j]; x1[j] = x2[j]; x2[j] = cur[j];
        }
        u32x4 w; w.x = cvt_pk_bf16(o[0], o[1]); w.y = cvt_pk_bf16(o[2], o[3]); w.z = cvt_pk_bf16(o[4], o[5]); w.w = cvt_pk_bf16(o[6], o[7]);
        *(u32x4*)(p.xbc + (size_t)(r0 + rb * 8 + rr) * XS + ch0) = w;
        ob[rr][0] = w.x; ob[rr][1] = w.y; ob[rr][2] = w.z; ob[rr][3] = w.w;
    }
    if (ch0 >= 1024 && ch0 < 1280) {
        const int g = (ch0 - 1024) >> 7, n0 = (ch0 - 1024) & 127;
        bf16_t* bt = p.BT + ((size_t)(ci * 2 + g) * 128 + n0) * 64 + rb * 8;
#pragma unroll
        for (int j = 0; j < 8; ++j) {
            unsigned e[8];
#pragma unroll
            for (int rr = 0; rr < 8; ++rr) e[rr] = (j & 1) ? (ob[rr][j >> 1] >> 16) : (ob[rr][j >> 1] & 0xffffu);
            u32x4 w; w.x = e[0] | (e[1] << 16); w.y = e[2] | (e[3] << 16); w.z = e[4] | (e[5] << 16); w.w = e[6] | (e[7] << 16);
            *(u32x4*)(bt + (size_t)j * 64) = w;
        }
    }
    if (rb == 7 && (!prompt || c == 63)) {
        float* dst = prompt ? p.out + O_CONVP + (size_t)(ci >> 6) * 3 * XS + ch0 : p.out + O_CONVS + (size_t)(ci - 512) * 3 * XS + ch0;
#pragma unroll
        for (int q = 0; q < 2; ++q) {
            *(f32x4*)(dst + 0 * XS + q * 4) = (f32x4){x0[q * 4], x0[q * 4 + 1], x0[q * 4 + 2], x0[q * 4 + 3]};
            *(f32x4*)(dst + 1 * XS + q * 4) = (f32x4){x1[q * 4], x1[q * 4 + 1], x1[q * 4 + 2], x1[q * 4 + 3]};
            *(f32x4*)(dst + 2 * XS + q * 4) = (f32x4){x2[q * 4], x2[q * 4 + 1], x2[q * 4 + 2], x2[q * 4 + 3]};
        }
    }
}

__device__ __forceinline__ void dt_item(const Params& p, LAS unsigned char* lds, int ci) {
    const int tid = threadIdx.x, lane = tid & 63, wid = tid >> 6, fr = lane & 15, fq = lane >> 4;
    const int r0 = ci * 64;
    LAS float* sDt = (LAS float*)lds;
    __syncthreads();
    if (wid < 4) {
        f32x4 acc = (f32x4){0.f, 0.f, 0.f, 0.f};
        const bf16_t* ap = p.xn + (size_t)(r0 + wid * 16 + fr) * DM + fq * 8;
        const bf16_t* bp = p.WdtT + (size_t)fr * 1024 + fq * 8;
#pragma unroll 8
        for (int kk = 0; kk < 32; ++kk) acc = MFMA16(*(const bf16x8*)(ap + kk * 32), *(const bf16x8*)(bp + kk * 32), acc);
        const float bias = p.dt_bias[fr];
#pragma unroll
        for (int j = 0; j < 4; ++j) {
            const float xx = acc[j] + bias;
            const float dtv = xx > 20.f ? xx : log1pf(__expf(xx));
            sDt[fr * 64 + wid * 16 + fq * 4 + j] = dtv;
        }
    }
    __syncthreads();
#pragma unroll
    for (int hh = 0; hh < 2; ++hh) {
        const int hd = wid + hh * 8;
        const float dtv = sDt[hd * 64 + lane];
        const float a = -__expf(p.a_log[hd]);
        float v = dtv * a;
#pragma unroll
        for (int o = 1; o < 64; o <<= 1) { const float t = __shfl_up(v, o); if (lane >= o) v += t; }
        p.dtT[((size_t)ci * 16 + hd) * 64 + lane] = dtv;
        p.acT[((size_t)ci * 16 + hd) * 64 + lane] = v;
    }
}

__device__ __forceinline__ void phase2a(const Params& p, LAS unsigned char* lds) {
    const int G = gridDim.x;
    for (int it = blockIdx.x; it < 2176; it += G) {
        if (it < 1632) conv_sub(p, it / 3, it % 3);
        else dt_item(p, lds, it - 1632);
    }
}

struct SsdA { bf16x8 xc; bf16x8 Bf[2][4]; float dt_lane, ac_lane; f32x4 ac_s[2], dt_s[2]; };
struct SsdB { bf16x8 Cf[4]; bf16x8 BTf[2]; u32x2 zz[2]; u32x2 xs[2]; float ac_l, ac63; };

constexpr int L_XT = 0, L_XDD = 9216, L_MX = 18432, L_HL = 27648;

__device__ __forceinline__ void ssd_load(const Params& p, int r0, int hd, int g, int wid, int lane, SsdA& a, SsdB& b) {
    const int fr = lane & 15, fq = lane >> 4, lt = wid >> 1, ci = r0 >> 6;
    const bf16_t* xb = p.xbc + (size_t)r0 * XS;
    a.xc = *(const bf16x8*)(xb + (size_t)lane * XS + hd * 64 + wid * 8);
    const float* dtp = p.dtT + ((size_t)ci * 16 + hd) * 64;
    const float* acp = p.acT + ((size_t)ci * 16 + hd) * 64;
    a.dt_lane = dtp[lane]; a.ac_lane = acp[lane];
#pragma unroll
    for (int i = 0; i < 2; ++i) {
        const int st = (wid & 1) * 2 + i;
#pragma unroll
        for (int kk = 0; kk < 4; ++kk) a.Bf[i][kk] = *(const bf16x8*)(xb + (size_t)(st * 16 + fr) * XS + 1024 + g * 128 + kk * 32 + fq * 8);
        a.ac_s[i] = *(const f32x4*)(acp + st * 16 + fq * 4);
        a.dt_s[i] = *(const f32x4*)(dtp + st * 16 + fq * 4);
        const int pt = st;
        b.zz[i] = *(const u32x2*)(p.h + (size_t)(r0 + lt * 16 + fr) * HS + 3072 + hd * 64 + pt * 16 + fq * 4);
        b.xs[i] = *(const u32x2*)(xb + (size_t)(lt * 16 + fr) * XS + hd * 64 + pt * 16 + fq * 4);
    }
#pragma unroll
    for (int kk = 0; kk < 4; ++kk) b.Cf[kk] = *(const bf16x8*)(xb + (size_t)(lt * 16 + fr) * XS + 1280 + g * 128 + kk * 32 + fq * 8);
#pragma unroll
    for (int kk = 0; kk < 2; ++kk) b.BTf[kk] = *(const bf16x8*)(p.BT + ((size_t)(ci * 2 + g) * 128 + wid * 16 + fr) * 64 + kk * 32 + fq * 8);
    b.ac_l = acp[lt * 16 + fr]; b.ac63 = acp[63];
}

__device__ __forceinline__ void ssd_item(const Params& p, LAS unsigned char* lds, int seq, int hd) {
    const int tid = threadIdx.x, lane = tid & 63, wid = __builtin_amdgcn_readfirstlane(tid >> 6), fr = lane & 15, fq = lane >> 4, lt = wid >> 1;
    const bool prompt = seq < 8;
    const int nch = prompt ? 64 : 1;
    const int rbase = prompt ? seq * 4096 : T_PROMPT + (seq - 8) * 64;
    const int g = hd >> 3;
    const float Dsk = p.d_skip[hd];
    f32x4 hT[4];
    float* hout = prompt ? p.out + O_SSMP + (size_t)(seq * 16 + hd) * 8192 : p.out + O_SSMS + (size_t)((seq - 8) * 16 + hd) * 8192;
    if (prompt) {
#pragma unroll
        for (int pt = 0; pt < 4; ++pt) hT[pt] = (f32x4){0.f, 0.f, 0.f, 0.f};
    } else {
        const float* h0 = p.state_ssm + (size_t)((seq - 8) * 16 + hd) * 8192;
#pragma unroll
        for (int pt = 0; pt < 4; ++pt) hT[pt] = *(const f32x4*)(h0 + (size_t)(pt * 16 + fr) * 128 + wid * 16 + fq * 4);
    }
    LAS bf16_t* xT = (LAS bf16_t*)(lds + L_XT); LAS bf16_t* xdd = (LAS bf16_t*)(lds + L_XDD);
    SsdA a; SsdB b;
    ssd_load(p, rbase, hd, g, wid, lane, a, b);
#pragma unroll 1
    for (int c = 0; c < nch; ++c) {
        const int r0 = rbase + c * 64;
        {
            const float decl = __expf(b.ac63 - a.ac_lane) * a.dt_lane;
            float xf[8]; unpack8(a.xc, xf);
#pragma unroll
            for (int j = 0; j < 8; ++j) {
                xT[(wid * 8 + j) * 72 + lane] = (bf16_t)a.xc[j];
                xdd[(wid * 8 + j) * 72 + lane] = (bf16_t)(cvt_pk_bf16(xf[j] * decl, 0.f) & 0xffffu);
            }
#pragma unroll
            for (int pt = 0; pt < 4; ++pt) {
                u32x2 w; w.x = cvt_pk_bf16(hT[pt][0], hT[pt][1]); w.y = cvt_pk_bf16(hT[pt][2], hT[pt][3]);
                *(LAS u32x2*)(lds + L_HL + ((pt * 16 + fr) * 136 + wid * 16 + fq * 4) * 2) = w;
            }
            const int lidx = lt * 16 + fr;
#pragma unroll
            for (int i = 0; i < 2; ++i) {
                const int st = (wid & 1) * 2 + i;
                f32x4 cb = (f32x4){0.f, 0.f, 0.f, 0.f};
#pragma unroll
                for (int kk = 0; kk < 4; ++kk) cb = MFMA16(a.Bf[i][kk], b.Cf[kk], cb);
                float m[4];
#pragma unroll
                for (int j = 0; j < 4; ++j) {
                    const int s = st * 16 + fq * 4 + j;
                    const float diff = fminf(b.ac_l - a.ac_s[i][j], 0.f);
                    m[j] = (s <= lidx) ? cb[j] * __expf(diff) * a.dt_s[i][j] : 0.f;
                }
                u32x2 w; w.x = cvt_pk_bf16(m[0], m[1]); w.y = cvt_pk_bf16(m[2], m[3]);
                *(LAS u32x2*)(lds + L_MX + (lidx * 72 + st * 16 + fq * 4) * 2) = w;
            }
        }
        __syncthreads();
        SsdB bn = b;
        if (c + 1 < nch) ssd_load(p, r0 + 64, hd, g, wid, lane, a, bn);
        {
            const float el = __expf(b.ac_l);
            float ss = 0.f;
#pragma unroll
            for (int i = 0; i < 2; ++i) {
                const int pt = (wid & 1) * 2 + i;
                f32x4 yd = (f32x4){0.f, 0.f, 0.f, 0.f}, yo = (f32x4){0.f, 0.f, 0.f, 0.f};
#pragma unroll
                for (int kk = 0; kk < 2; ++kk) {
                    const bf16x8 A = *(const LAS bf16x8*)(lds + L_XT + ((pt * 16 + fr) * 72 + kk * 32 + fq * 8) * 2);
                    const bf16x8 Bo = *(const LAS bf16x8*)(lds + L_MX + ((lt * 16 + fr) * 72 + kk * 32 + fq * 8) * 2);
                    yd = MFMA16(A, Bo, yd);
                }
#pragma unroll
                for (int kk = 0; kk < 4; ++kk) {
                    const bf16x8 A = *(const LAS bf16x8*)(lds + L_HL + ((pt * 16 + fr) * 136 + kk * 32 + fq * 8) * 2);
                    yo = MFMA16(A, b.Cf[kk], yo);
                }
                const float xv[4] = {bf_lo(b.xs[i].x), bf_hi(b.xs[i].x), bf_lo(b.xs[i].y), bf_hi(b.xs[i].y)};
                const float zv[4] = {bf_lo(b.zz[i].x), bf_hi(b.zz[i].x), bf_lo(b.zz[i].y), bf_hi(b.zz[i].y)};
                float yz[4];
#pragma unroll
                for (int j = 0; j < 4; ++j) { const float y = yd[j] + el * yo[j] + Dsk * xv[j]; yz[j] = y * silu_f(zv[j]); ss += yz[j] * yz[j]; }
                u32x2 w; w.x = cvt_pk_bf16(yz[0], yz[1]); w.y = cvt_pk_bf16(yz[2], yz[3]);
                *(u32x2*)(p.h + (size_t)(r0 + lt * 16 + fr) * HS + 3072 + hd * 64 + pt * 16 + fq * 4) = w;
            }
            ss += __shfl_xor(ss, 16); ss += __shfl_xor(ss, 32);
            if (fq == 0) atomicAdd(p.ssq + r0 + lt * 16 + fr, ss);
            const float cd = __expf(b.ac63);
#pragma unroll
            for (int pt = 0; pt < 4; ++pt) {
                f32x4 acc = hT[pt] * cd;
#pragma unroll
                for (int kk = 0; kk < 2; ++kk) {
                    const bf16x8 Bo = *(const LAS bf16x8*)(lds + L_XDD + ((pt * 16 + fr) * 72 + kk * 32 + fq * 8) * 2);
                    acc = MFMA16(b.BTf[kk], Bo, acc);
                }
                hT[pt] = acc;
            }
        }
        __syncthreads();
        b = bn;
    }
#pragma unroll
    for (int pt = 0; pt < 4; ++pt) *(f32x4*)(hout + (size_t)(pt * 16 + fr) * 128 + wid * 16 + fq * 4) = hT[pt];
}

__device__ __forceinline__ void gmlp_item(const Params& p, LAS unsigned char* lds, int item) {
    const int tid = threadIdx.x, lane = tid & 63, wid = __builtin_amdgcn_readfirstlane(tid >> 6), fr = lane & 15, fq = lane >> 4;
    const bool sample = item >= 2048;
    const int hd = item & 7;
    const int r0 = sample ? T_PROMPT + ((item - 2048) >> 3) * 128 : (item >> 3) * 128;
    LAS bf16_t* vnT = (LAS bf16_t*)lds;
    float mu[2], rs[2];
#pragma unroll
    for (int q = 0; q < 2; ++q) {
        const float* sp = p.stats + (size_t)(r0 + lane + 64 * q) * 32;
        float s = 0.f, ss = 0.f;
#pragma unroll
        for (int k = 0; k < 8; ++k) { const f32x4 v = *(const f32x4*)(sp + k * 4); s += v[0] + v[2]; ss += v[1] + v[3]; }
        const float m = s * (1.f / 1024.f);
        const float var = fmaxf(ss * (1.f / 1024.f) - m * m, 0.f);
        mu[q] = m; rs[q] = rsqrtf(var + EPS);
    }
#pragma unroll
    for (int dd = 0; dd < 2; ++dd) {
        const int dg = wid + 8 * dd;
        float lw[8], lb[8];
#pragma unroll
        for (int q = 0; q < 2; ++q) {
            const f32x4 a = *(const f32x4*)(p.ln_w + hd * 128 + dg * 8 + q * 4), b = *(const f32x4*)(p.ln_b + hd * 128 + dg * 8 + q * 4);
#pragma unroll
            for (int j = 0; j < 4; ++j) { lw[q * 4 + j] = a[j]; lb[q * 4 + j] = b[j]; }
        }
#pragma unroll
        for (int q = 0; q < 2; ++q) {
            const int s = lane + 64 * q, row = r0 + s;
            float v[8]; unpack8(*(const bf16x8*)(p.h + (size_t)row * HS + 1024 + hd * 128 + dg * 8), v);
#pragma unroll
            for (int j = 0; j < 8; ++j) v[j] = (v[j] - mu[q]) * rs[q] * lw[j] + lb[j];
#pragma unroll
            for (int j = 0; j < 8; ++j) vnT[(dg * 8 + j) * 136 + s] = (bf16_t)(cvt_pk_bf16(v[j], 0.f) & 0xffffu);
            if (sample) {
                float* vo = p.out + O_VS + (size_t)(row - T_PROMPT) * 1024 + hd * 128 + dg * 8;
                *(f32x4*)(vo) = (f32x4){v[0], v[1], v[2], v[3]};
                *(f32x4*)(vo + 4) = (f32x4){v[4], v[5], v[6], v[7]};
            }
        }
    }
    __syncthreads();
    const int wt = sample ? (wid & 3) : wid;
    const int kk0 = sample ? ((wid >> 2) * 2) : 0;
    const int nkk = sample ? 2 : (wid < 4 ? 2 : 4);
    bf16x8 Wf[4];
#pragma unroll
    for (int kk = 0; kk < 4; ++kk) Wf[kk] = *(const bf16x8*)(p.Wm + ((size_t)hd * 128 + wt * 16 + fr) * 128 + (kk < nkk ? kk : 0) * 32 + fq * 8);
    const float bias = p.gbs[hd * 128 + wt * 16 + fr];
    const int row = r0 + wid * 16 + fr;
    bf16_t* hr = p.h + (size_t)row * HS + hd * 128 + fq * 4;
#pragma unroll 2
    for (int dt_ = 0; dt_ < 8; ++dt_) {
        f32x4 acc = (f32x4){0.f, 0.f, 0.f, 0.f};
#pragma unroll
        for (int kk = 0; kk < 4; ++kk) {
            if (kk < nkk) {
                const bf16x8 A = *(const LAS bf16x8*)(lds + ((dt_ * 16 + fr) * 136 + (kk0 + kk) * 32 + fq * 8) * 2);
                acc = MFMA16(A, Wf[kk], acc);
            }
        }
        const u32x2 u4 = *(const u32x2*)(hr + dt_ * 16);
        const u32x2 g4 = *(const u32x2*)(hr + 2048 + dt_ * 16);
        const float uv[4] = {bf_lo(u4.x), bf_hi(u4.x), bf_lo(u4.y), bf_hi(u4.y)};
        const float gv[4] = {bf_lo(g4.x), bf_hi(g4.x), bf_lo(g4.y), bf_hi(g4.y)};
        float o[4];
#pragma unroll
        for (int j = 0; j < 4; ++j) o[j] = uv[j] * (acc[j] + bias) * silu_f(gv[j]);
        u32x2 w; w.x = cvt_pk_bf16(o[0], o[1]); w.y = cvt_pk_bf16(o[2], o[3]);
        *(u32x2*)(hr + dt_ * 16) = w;
    }
}

constexpr int N_POOL = 128 + 512 + 2176;
__device__ __forceinline__ void phase2b(const Params& p, LAS unsigned char* lds) {
    LAS int* sItem = (LAS int*)(lds + LDS_ITEM_OFF);
    for (;;) {
        __syncthreads();
        if (threadIdx.x == 0) *sItem = (int)atomicAdd(p.ctr, 1u);
        __syncthreads();
        const int it = *sItem;
        if (it >= N_POOL) break;
        if (it < 128) ssd_item(p, lds, it >> 4, it & 15);
        else if (it < 640) ssd_item(p, lds, 8 + ((it - 128) >> 4), (it - 128) & 15);
        else gmlp_item(p, lds, it - 640);
    }
}

__device__ __forceinline__ void phase4(const Params& p) {
    const int tid = threadIdx.x, lane = tid & 63, wid = tid >> 6;
    const int G = gridDim.x;
    f32x4 nw[4];
#pragma unroll
    for (int i = 0; i < 4; ++i) nw[i] = *(const f32x4*)(p.norm_f_w + i * 256 + lane * 4);
    for (int row = blockIdx.x * 8 + wid; row < T_ALL; row += G * 8) {
        const float* fp = p.fpart + (size_t)row * 16;
        float ss = 0.f;
#pragma unroll
        for (int k = 0; k < 4; ++k) { const f32x4 v = *(const f32x4*)(fp + k * 4); ss += (v[0] + v[1]) + (v[2] + v[3]); }
        const float rs = rsqrtf(ss * (1.f / 1024.f) + EPS);
        float* o = p.out + (size_t)row * DM;
#pragma unroll
        for (int i = 0; i < 4; ++i) { f32x4 v = *(const f32x4*)(o + i * 256 + lane * 4); v = v * rs * nw[i]; *(f32x4*)(o + i * 256 + lane * 4) = v; }
    }
}

#if ONE_LAUNCH
__global__ void __launch_bounds__(512) mega_kernel(Params p) {
    extern __shared__ __attribute__((aligned(16))) unsigned char smem[];
    LAS unsigned char* lds = (LAS unsigned char*)smem;
    cg::grid_group grid = cg::this_grid();
    phase0(p, lds); grid.sync();
    gemm_phase<1>(p, lds); grid.sync();
    phase2a(p, lds); grid.sync();
    phase2b(p, lds); grid.sync();
    gemm_phase<2>(p, lds); grid.sync();
    phase4(p);
}
#else
template <int PH> __global__ void __launch_bounds__(512) phase_kernel(Params p) {
    extern __shared__ __attribute__((aligned(16))) unsigned char smem[];
    LAS unsigned char* lds = (LAS unsigned char*)smem;
    if (PH == 0) phase0(p, lds);
    if (PH == 1) gemm_phase<1>(p, lds);
    if (PH == 2) phase2a(p, lds);
    if (PH == 3) phase2b(p, lds);
    if (PH == 4) gemm_phase<2>(p, lds);
    if (PH == 5) phase4(p);
}
#endif

extern "C" void kernel_launch(void* const* d_in, const int* in_sizes, int n_in, void* d_out, int out_size, void* d_ws, size_t ws_size, hipStream_t stream) {
    static int grid = 0;
    if (grid == 0) {
        if (n_in != 18 || ws_size < WS_END) { fprintf(stderr, "kernel_launch: need 18 inputs and >= %zu bytes of workspace (got %d, %zu)\n", (size_t)WS_END, n_in, ws_size); grid = -1; return; }
        int dev = 0, cus = 0, per_cu = 0;
        hipGetDevice(&dev);
        hipDeviceGetAttribute(&cus, hipDeviceAttributeMultiprocessorCount, dev);
#if ONE_LAUNCH
        hipFuncSetAttribute((const void*)mega_kernel, hipFuncAttributeMaxDynamicSharedMemorySize, LDS_BYTES);
        hipOccupancyMaxActiveBlocksPerMultiprocessor(&per_cu, (const void*)mega_kernel, 512, LDS_BYTES);
        if (per_cu < 1) { fprintf(stderr, "kernel_launch: occupancy query says %d blocks per CU\n", per_cu); per_cu = 1; }
        grid = cus * per_cu;
#else
        hipFuncSetAttribute((const void*)phase_kernel<0>, hipFuncAttributeMaxDynamicSharedMemorySize, LDS_BYTES);
        hipFuncSetAttribute((const void*)phase_kernel<1>, hipFuncAttributeMaxDynamicSharedMemorySize, LDS_BYTES);
        hipFuncSetAttribute((const void*)phase_kernel<2>, hipFuncAttributeMaxDynamicSharedMemorySize, LDS_BYTES);
        hipFuncSetAttribute((const void*)phase_kernel<3>, hipFuncAttributeMaxDynamicSharedMemorySize, LDS_BYTES);
        hipFuncSetAttribute((const void*)phase_kernel<4>, hipFuncAttributeMaxDynamicSharedMemorySize, LDS_BYTES);
        hipFuncSetAttribute((const void*)phase_kernel<5>, hipFuncAttributeMaxDynamicSharedMemorySize, LDS_BYTES);
        (void)per_cu;
        grid = cus;
#endif
    }
    if (grid < 0) return;
    Params p{};
    p.x_prompt = (const float*)d_in[0]; p.x_sample = (const float*)d_in[1]; p.state_ssm = (const float*)d_in[2]; p.state_conv = (const float*)d_in[3];
    p.norm_in_w = (const float*)d_in[4]; p.w_in = (const float*)d_in[5]; p.ln_w = (const float*)d_in[6]; p.ln_b = (const float*)d_in[7];
    p.gws = (const float*)d_in[8]; p.gbs = (const float*)d_in[9]; p.conv_w = (const float*)d_in[10]; p.conv_b = (const float*)d_in[11];
    p.dt_bias = (const float*)d_in[12]; p.a_log = (const float*)d_in[13]; p.d_skip = (const float*)d_in[14]; p.ssm_norm_w = (const float*)d_in[15];
    p.w_out = (const float*)d_in[16]; p.norm_f_w = (const float*)d_in[17];
    p.out = (float*)d_out;
    unsigned char* ws = (unsigned char*)d_ws;
    p.h = (bf16_t*)(ws + WS_H); p.xn = (bf16_t*)(ws + WS_XN); p.WinT = (bf16_t*)(ws + WS_WINT); p.WoutT = (bf16_t*)(ws + WS_WOUTT);
    p.WdtT = (bf16_t*)(ws + WS_WDTT); p.Wm = (bf16_t*)(ws + WS_WM); p.BT = (bf16_t*)(ws + WS_BT);
    p.xbc = (bf16_t*)d_out;
    p.stats = (float*)(ws + WS_STATS); p.ssq = (float*)(ws + WS_SSQ); p.fpart = (float*)(ws + WS_FPART);
    p.dtT = (float*)(ws + WS_DTT); p.acT = (float*)(ws + WS_ACT); p.ctr = (unsigned*)(ws + WS_CTR);
#if ONE_LAUNCH
    void* args[] = {&p};
    hipError_t e = hipLaunchCooperativeKernel((const void*)mega_kernel, dim3(grid), dim3(512), args, LDS_BYTES, stream);
    if (e != hipSuccess) fprintf(stderr, "cooperative launch failed: %s (grid %d)\n", hipGetErrorString(e), grid);
#else
    hipLaunchKernelGGL(phase_kernel<0>, dim3(grid), dim3(512), LDS_BYTES, stream, p);
    hipLaunchKernelGGL(phase_kernel<1>, dim3(grid), dim3(512), LDS_BYTES, stream, p);
    hipLaunchKernelGGL(phase_kernel<2>, dim3(grid), dim3(512), LDS_BYTES, stream, p);
    hipLaunchKernelGGL(phase_kernel<3>, dim3(grid), dim3(512), LDS_BYTES, stream, p);
    hipLaunchKernelGGL(phase_kernel<4>, dim3(grid), dim3(512), LDS_BYTES, stream, p);
    hipLaunchKernelGGL(phase_kernel<5>, dim3(grid), dim3(512), LDS_BYTES, stream, p);
#endif
}
```

```cpp
#include <hip/hip_runtime.h>
#include <hip/hip_cooperative_groups.h>
#include <cstdio>
namespace cg = cooperative_groups;

#ifndef ONE_LAUNCH
#define ONE_LAUNCH 1
#endif

#ifndef DIAG
#define DIAG 0
#endif
#ifndef DIAG_A
#define DIAG_A 0
#endif
#ifndef DIAG_B
#define DIAG_B 1
#endif
#define LAS __attribute__((address_space(3)))
typedef unsigned short bf16_t;
typedef short bf16x8 __attribute__((ext_vector_type(8)));
typedef float f32x4 __attribute__((ext_vector_type(4)));
typedef float f32x2 __attribute__((ext_vector_type(2)));
typedef unsigned u32x4 __attribute__((ext_vector_type(4)));
typedef unsigned u32x2 __attribute__((ext_vector_type(2)));

constexpr int T_ALL = 34816, T_PROMPT = 32768, DM = 1024, HS = 5632  , DIN = 5648;
constexpr int XS = 1536;
constexpr int XSB = 2048;
constexpr float EPS = 1e-5f;
constexpr int LDS_BYTES = 131072 + 1024;
constexpr int LDS_ITEM_OFF = 131072;

constexpr size_t O_Y = 0, O_SSMP = 35651584, O_CONVP = 36700160, O_SSMS = 36737024, O_CONVS = 40931328, O_VS = 41078784;

struct Params {
    const float* x_prompt; const float* x_sample; const float* state_ssm; const float* state_conv;
    const float* norm_in_w; const float* w_in; const float* ln_w; const float* ln_b; const float* gws; const float* gbs;
    const float* conv_w; const float* conv_b; const float* dt_bias; const float* a_log; const float* d_skip; const float* ssm_norm_w;
    const float* w_out; const float* norm_f_w;
    float* out;
    bf16_t* h; bf16_t* xn; bf16_t* WinT; bf16_t* WoutT; bf16_t* WdtT; bf16_t* Wm; bf16_t* BT; bf16_t* xbc;
    float* stats; float* ssq; float* fpart; float* dtraw; float* dtT; float* acT; unsigned* ctr; unsigned* bar;
};

constexpr size_t WS_H = 0;
constexpr size_t WS_XN = WS_H + (size_t)T_ALL * HS * 2;
constexpr size_t WS_WINT = WS_XN + (size_t)T_ALL * DM * 2;
constexpr size_t WS_WOUTT = WS_WINT + (size_t)5632 * 1024 * 2;
constexpr size_t WS_WDTT = WS_WOUTT + (size_t)1024 * 2048 * 2;
constexpr size_t WS_WM = WS_WDTT + (size_t)16 * 1024 * 2;
constexpr size_t WS_BT = WS_WM + (size_t)8 * 128 * 128 * 2;
constexpr size_t WS_STATS = WS_BT + (size_t)544 * 2 * 128 * 64 * 2;
constexpr size_t WS_SSQ = WS_STATS + (size_t)T_ALL * 32 * 4;
constexpr size_t WS_FPART = WS_SSQ + (size_t)T_ALL * 4;
constexpr size_t WS_DTT = WS_FPART + (size_t)T_ALL * 16 * 4;
constexpr size_t WS_ACT = WS_DTT + (size_t)T_ALL * 16 * 4;
constexpr size_t WS_CTR = WS_ACT + (size_t)T_ALL * 16 * 4;
constexpr size_t WS_BAR = WS_CTR + 1024;
constexpr size_t WS_DTRAW = WS_BAR + 16384;
constexpr size_t WS_END = WS_DTRAW + (size_t)T_ALL * 16 * 4;

__device__ __forceinline__ unsigned cvt_pk_bf16(float lo, float hi) { unsigned r; asm("v_cvt_pk_bf16_f32 %0, %1, %2" : "=v"(r) : "v"(lo), "v"(hi)); return r; }
__device__ __forceinline__ float bf_lo(unsigned w) { return __uint_as_float(w << 16); }
__device__ __forceinline__ float bf_hi(unsigned w) { return __uint_as_float(w & 0xffff0000u); }
__device__ __forceinline__ float silu_f(float x) { return x * __builtin_amdgcn_rcpf(1.f + __expf(-x)); }
__device__ __forceinline__ const float* xrow_ptr(const Params& p, int row) {
    return row < T_PROMPT ? p.x_prompt + (size_t)row * DM : p.x_sample + (size_t)(row - T_PROMPT) * DM;
}
#define MFMA16(a, b, c) __builtin_amdgcn_mfma_f32_16x16x32_bf16((a), (b), (c), 0, 0, 0)

__device__ __forceinline__ void transpose_tile(const float* __restrict__ src, int ldn, int k0, int n0, const float* __restrict__ scale, int s0,
                                               bf16_t* __restrict__ dst, int ldk, int kd0, LAS float* tl) {
    const int tid = threadIdx.x;
    __syncthreads();
    {
        const int r = tid >> 4, c4 = tid & 15;
#pragma unroll
        for (int i = 0; i < 2; ++i) {
            const int k = r + 32 * i;
            f32x4 v = *(const f32x4*)(src + (size_t)(k0 + k) * ldn + n0 + c4 * 4);
            const float sc = scale ? scale[s0 + k] : 1.f;
            tl[k * 65 + c4 * 4 + 0] = v[0] * sc; tl[k * 65 + c4 * 4 + 1] = v[1] * sc; tl[k * 65 + c4 * 4 + 2] = v[2] * sc; tl[k * 65 + c4 * 4 + 3] = v[3] * sc;
        }
    }
    __syncthreads();
    {
        const int n = tid >> 3, kg = tid & 7;
        float f[8];
#pragma unroll
        for (int j = 0; j < 8; ++j) f[j] = tl[(kg * 8 + j) * 65 + n];
        u32x4 w; w.x = cvt_pk_bf16(f[0], f[1]); w.y = cvt_pk_bf16(f[2], f[3]); w.z = cvt_pk_bf16(f[4], f[5]); w.w = cvt_pk_bf16(f[6], f[7]);
        *(u32x4*)(dst + (size_t)(n0 + n) * ldk + kd0 + kg * 8) = w;
    }
}

__device__ __forceinline__ void phase0(const Params& p, LAS unsigned char* lds) {
    const int tid = threadIdx.x, lane = tid & 63, wid = tid >> 6;
    const int G = gridDim.x, blk = blockIdx.x;
    for (int i = blk * 512 + tid; i < T_ALL; i += G * 512) p.ssq[i] = 0.f;
    if (blk == 0 && tid < 64) p.ctr[tid] = 0u;
    for (int i = blk * 512 + tid; i < 16 * 1024; i += G * 512) {
        const int j = i >> 10, k = i & 1023;
        p.WdtT[i] = (bf16_t)(cvt_pk_bf16(p.w_in[(size_t)k * DIN + 5632 + j] * p.norm_in_w[k], 0.f) & 0xffffu);
    }
    for (int i = blk * 512 + tid; i < 8 * 128 * 128; i += G * 512) {
        const int t = (i >> 7) & 127, s = i & 127;
        float v = p.gws[i]; if ((s >> 6) > (t >> 6)) v = 0.f;
        p.Wm[i] = (bf16_t)(cvt_pk_bf16(v, 0.f) & 0xffffu);
    }
    LAS float* tl = (LAS float*)lds;
    for (int base = blk * 4; base < 1920; base += G * 4) {
        const float* srcp[4]; const float* scp[4]; bf16_t* dstp[4]; int ldn[4], ldk[4];
#pragma unroll
        for (int t = 0; t < 4; ++t) {
            const int ti = base + t;
            if (ti < 1408) {
                const int kt = ti / 88, nt_ = ti % 88;
                srcp[t] = p.w_in + (size_t)(kt * 64) * DIN + nt_ * 64; ldn[t] = DIN; scp[t] = p.norm_in_w + kt * 64;
                dstp[t] = p.WinT + (size_t)(nt_ * 64) * 1024 + kt * 64; ldk[t] = 1024;
            } else {
                const int t2 = ti - 1408, kt = t2 >> 4, nt_ = t2 & 15, k0 = kt * 64;
                srcp[t] = p.w_out + (size_t)k0 * 1024 + nt_ * 64; ldn[t] = 1024;
                scp[t] = k0 >= 1024 ? p.ssm_norm_w + (k0 - 1024) : nullptr;
                dstp[t] = p.WoutT + (size_t)(nt_ * 64) * 2048 + (k0 >= 1024 ? k0 - 1024 : k0 + 1024);
                ldk[t] = 2048;
            }
        }
        f32x4 v[4][2]; float sc[4][2];
        {
            const int r = tid >> 4, c4 = tid & 15;
#pragma unroll
            for (int t = 0; t < 4; ++t)
                if (base + t < 1920) {
#pragma unroll
                    for (int i = 0; i < 2; ++i) {
                        v[t][i] = *(const f32x4*)(srcp[t] + (size_t)(r + 32 * i) * ldn[t] + c4 * 4);
                        sc[t][i] = scp[t] ? scp[t][r + 32 * i] : 1.f;
                    }
                }
            __syncthreads();
#pragma unroll
            for (int t = 0; t < 4; ++t)
                if (base + t < 1920) {
#pragma unroll
                    for (int i = 0; i < 2; ++i) {
                        LAS float* d = tl + t * (64 * 65) + (r + 32 * i) * 65 + c4 * 4;
                        d[0] = v[t][i][0] * sc[t][i]; d[1] = v[t][i][1] * sc[t][i]; d[2] = v[t][i][2] * sc[t][i]; d[3] = v[t][i][3] * sc[t][i];
                    }
                }
        }
        __syncthreads();
        {
            const int n = tid >> 3, kg = tid & 7;
#pragma unroll
            for (int t = 0; t < 4; ++t)
                if (base + t < 1920) {
                    float f[8];
#pragma unroll
                    for (int j = 0; j < 8; ++j) f[j] = tl[t * (64 * 65) + (kg * 8 + j) * 65 + n];
                    u32x4 w; w.x = cvt_pk_bf16(f[0], f[1]); w.y = cvt_pk_bf16(f[2], f[3]); w.z = cvt_pk_bf16(f[4], f[5]); w.w = cvt_pk_bf16(f[6], f[7]);
                    *(u32x4*)(dstp[t] + (size_t)n * ldk[t] + kg * 8) = w;
                }
        }
    }
    constexpr int RP = 3;
    for (int row0 = blk * 8 + wid; row0 < T_ALL; row0 += G * 8 * RP) {
        f32x4 v[RP][4];
#pragma unroll
        for (int r = 0; r < RP; ++r) {
            const int row = row0 + r * G * 8;
            if (row < T_ALL) {
                const float* src = xrow_ptr(p, row);
#pragma unroll
                for (int i = 0; i < 4; ++i) v[r][i] = __builtin_nontemporal_load((const f32x4*)(src + i * 256 + lane * 4));
            }
        }
#pragma unroll
        for (int r = 0; r < RP; ++r) {
            const int row = row0 + r * G * 8;
            if (row < T_ALL) {
                float ss = 0.f;
#pragma unroll
                for (int i = 0; i < 4; ++i) ss += v[r][i][0] * v[r][i][0] + v[r][i][1] * v[r][i][1] + v[r][i][2] * v[r][i][2] + v[r][i][3] * v[r][i][3];
#pragma unroll
                for (int o = 32; o >= 1; o >>= 1) ss += __shfl_xor(ss, o);
                const float rs = rsqrtf(ss * (1.f / 1024.f) + EPS);
#pragma unroll
                for (int i = 0; i < 4; ++i) {
                    u32x2 w; w.x = cvt_pk_bf16(v[r][i][0] * rs, v[r][i][1] * rs); w.y = cvt_pk_bf16(v[r][i][2] * rs, v[r][i][3] * rs);
                    *(u32x2*)(p.xn + (size_t)row * DM + i * 256 + lane * 4) = w;
                }
            }
        }
    }
}

constexpr int XCD_BAR_WORDS_C = 3456;
constexpr int PCNT_OFF = 3800;
constexpr int BM = 256, BK = 64, HALF = 128, HTB = HALF * BK * 2, NXCD = 8, WGM = 8;
__device__ __forceinline__ int lds_byte(int r, int c) { const int st = (r >> 4) * 2 + (c >> 5), rr = r & 15, cc = c & 31, ob = rr * 64 + cc * 2; return st * 1024 + (ob ^ (((ob >> 9) & 1) << 5)); }
__device__ __forceinline__ void stage_rc(int b, int& R, int& C) { const int st = b / 1024, sb = b % 1024, swz = sb ^ (((sb >> 9) & 1) << 5); R = (st >> 1) * 16 + swz / 64; C = (st & 1) * 32 + (swz % 64) / 2; }
__device__ __forceinline__ int perm32(int rho) { const int n = rho >> 4, i = rho & 15; return 8 * (i >> 2) + 4 * n + (i & 3); }
struct Unit { int pm, pn; };
template <bool B> struct BoolTag { static constexpr bool value = B; };

template <int MODE, bool SINGLE>
__device__ __forceinline__ bool unit_next(int i, int G, int c, Unit& u, int spm, int spn) {
    if (SINGLE) { u.pm = spm; u.pn = spn; return i == 0; }
    constexpr int nM = (MODE == 1) ? 136 : 128, nN = (MODE == 1) ? 22 : 4, nwg = nM * nN;
    const long L = (long)i * G + c; if (L >= nwg) return false;
    int wgid = (int)L; { const int q = nwg / NXCD, r = nwg % NXCD, xcd = wgid % NXCD, off = wgid / NXCD; wgid = (xcd < r ? xcd * (q + 1) : r * (q + 1) + (xcd - r) * q) + off; }
    const int nig = WGM * nN, gid = wgid / nig, fm = gid * WGM, gsz = (nM - fm) < WGM ? (nM - fm) : WGM;
    u.pm = fm + ((wgid % nig) % gsz); u.pn = (wgid % nig) / gsz; return true;
}

template <int MODE, bool SINGLE = false, bool FUSE = false>
__device__ __forceinline__ void gemm_phase(const Params& p, LAS unsigned char* lds, int spm = 0, int spn = 0) {
    constexpr int K = (MODE == 1) ? 1024 : 2048;
    constexpr int LDA = (MODE == 1) ? 1024 : HS;
    constexpr bool PERM = (MODE == 1);
    constexpr int nt = K / BK;
    const int tid = threadIdx.x, wid = __builtin_amdgcn_readfirstlane(tid >> 6), lane = tid & 63, wr = wid >> 2, wc = wid & 3, fr = lane & 15, fq = lane >> 4;
    const int G = gridDim.x, cblk = blockIdx.x;
    const char* Abase = (MODE == 1) ? (const char*)p.xn : (const char*)(p.h + 3072);
    const char* Bbase = (MODE == 1) ? (const char*)p.WinT : (const char*)p.WoutT;
    unsigned voffA[2], voffB[2];
#pragma unroll
    for (int i = 0; i < 2; ++i) { int R, C; stage_rc(tid * 16 + i * 8192, R, C); const int Rb = PERM ? ((R & ~31) + perm32(R & 31)) : R;
        voffA[i] = (unsigned)(R * LDA + C) * 2u; voffB[i] = (unsigned)(Rb * K + C) * 2u; }
    constexpr size_t kstep = (size_t)(BK * 2);
    constexpr size_t hstepA = (size_t)HALF * LDA * 2, tstepA = 2 * hstepA;
    constexpr size_t hstepB = (size_t)HALF * K * 2, tstepB = 2 * hstepB;
    const unsigned ldsw = (unsigned)wid * 1024u;
    const int aoff = lds_byte(wr * 64 + fr, fq * 8), boff = lds_byte(wc * 32 + fr, fq * 8);
#define AK(t) ((long)(t) * 128 + ((MODE == 2 && (t) >= 16) ? -8192L : 0L))
#define PG8_SA(b, h) (((b) * 2 + (h)) * HTB)
#define PG8_SB(b, h) ((4 + (b) * 2 + (h)) * HTB)
#define PG8_STAGE(bufoff, gbase, voff) do { _Pragma("unroll") for (int _i = 0; _i < 2; ++_i) \
        __builtin_amdgcn_global_load_lds((const unsigned*)((const char*)(gbase) + (voff)[_i]), (LAS unsigned*)(lds + (bufoff) + ldsw + _i * 8192), 16, 0, 0); } while (0)
#define PG8_LDA(dst, b, h) do { _Pragma("unroll") for (int m = 0; m < 4; ++m) _Pragma("unroll") for (int k = 0; k < 2; ++k) dst[m][k] = *(const LAS bf16x8*)(lds + PG8_SA(b, h) + aoff + m * 2048 + k * 1024); } while (0)
#define PG8_LDB(dst, b, h) do { _Pragma("unroll") for (int n = 0; n < 2; ++n) _Pragma("unroll") for (int k = 0; k < 2; ++k) dst[n][k] = *(const LAS bf16x8*)(lds + PG8_SB(b, h) + boff + n * 2048 + k * 1024); } while (0)
#define PG8_MMA(ai, bj, At, Bt) do { __builtin_amdgcn_s_setprio(1); _Pragma("unroll") for (int m = 0; m < 4; ++m) _Pragma("unroll") for (int n = 0; n < 2; ++n) _Pragma("unroll") for (int k = 0; k < 2; ++k) \
        acc[ai][bj][m][n] = __builtin_amdgcn_mfma_f32_16x16x32_bf16(Bt[n][k], At[m][k], acc[ai][bj][m][n], 0, 0, 0); __builtin_amdgcn_s_setprio(0); } while (0)
#define PG8_WAIT_V(n) asm volatile("s_waitcnt vmcnt(" #n ")" ::: "memory")
#define PG8_WAIT_L(n) asm volatile("s_waitcnt lgkmcnt(" #n ")" ::: "memory")
#define PG8_BAR __builtin_amdgcn_s_barrier()
#define PG8_SCHED __builtin_amdgcn_sched_barrier(0)
    Unit cur, nxt; int ui = 0;
    if (!unit_next<MODE, SINGLE>(0, G, cblk, cur, spm, spn)) return;
    f32x4 acc[2][2][4][2];
#pragma unroll
    for (int a = 0; a < 2; ++a)
#pragma unroll
        for (int b = 0; b < 2; ++b)
#pragma unroll
            for (int m = 0; m < 4; ++m)
#pragma unroll
                for (int n = 0; n < 2; ++n) acc[a][b][m][n] = (f32x4){0.f, 0.f, 0.f, 0.f};
    bf16x8 At[4][2], B0[2][2], B1[2][2];
    const char* cA = Abase + (size_t)cur.pm * tstepA; const char* cB = Bbase + (size_t)cur.pn * tstepB;
    PG8_STAGE(PG8_SB(0, 0), cB, voffB); PG8_STAGE(PG8_SA(0, 0), cA, voffA); PG8_STAGE(PG8_SB(0, 1), cB + hstepB, voffB); PG8_STAGE(PG8_SA(0, 1), cA + hstepA, voffA);
    if (wr == 1) PG8_BAR;
    PG8_WAIT_V(4); PG8_BAR;
    PG8_STAGE(PG8_SB(1, 0), cB + kstep, voffB); PG8_STAGE(PG8_SA(1, 0), cA + kstep, voffA); PG8_STAGE(PG8_SB(1, 1), cB + hstepB + kstep, voffB);
    PG8_WAIT_V(6); PG8_BAR;
    for (;;) {
        const bool has_next = unit_next<MODE, SINGLE>(ui + 1, G, cblk, nxt, spm, spn);
        const char* nA = has_next ? Abase + (size_t)nxt.pm * tstepA : cA; const char* nB = has_next ? Bbase + (size_t)nxt.pn * tstepB : cB;
#if DIAG == 3
        const unsigned long long tk0 = __builtin_amdgcn_s_memrealtime();
#endif
#pragma unroll 1
        for (int t = 0; t < nt; t += 2) {
            const bool last = (t == nt - 2);
            const char* a1 = cA + AK(t + 1);
            const char* a2 = last ? nA : cA + AK(t + 2); const char* b2 = last ? nB : cB + (size_t)(t + 2) * kstep;
            const char* a3 = last ? nA + kstep : cA + AK(t + 3); const char* b3 = b2 + kstep;
            if (MODE == 2 && t == 16) {
#pragma unroll
                for (int ai = 0; ai < 2; ++ai)
#pragma unroll
                    for (int m = 0; m < 4; ++m) {
                        const int row = cur.pm * BM + ai * HALF + wr * 64 + m * 16 + fr;
                        const float r = rsqrtf(p.ssq[row] * (1.f / 1024.f) + EPS);
#pragma unroll
                        for (int bj = 0; bj < 2; ++bj)
#pragma unroll
                            for (int n = 0; n < 2; ++n) acc[ai][bj][m][n] *= r;
                    }
            }
            PG8_LDB(B0, 0, 0); PG8_SCHED; PG8_LDA(At, 0, 0); PG8_STAGE(PG8_SA(1, 1), a1 + hstepA, voffA);
            PG8_WAIT_L(8); PG8_BAR; PG8_WAIT_L(0); PG8_MMA(0, 0, At, B0); PG8_BAR; PG8_SCHED;
            PG8_LDB(B1, 0, 1); PG8_STAGE(PG8_SB(0, 0), b2, voffB);
            PG8_BAR; PG8_WAIT_L(0); PG8_MMA(0, 1, At, B1); PG8_BAR;
            PG8_LDA(At, 0, 1); PG8_STAGE(PG8_SA(0, 0), a2, voffA);
            PG8_BAR; PG8_WAIT_L(0); PG8_MMA(1, 0, At, B0); PG8_BAR; PG8_SCHED;
            PG8_STAGE(PG8_SB(0, 1), b2 + hstepB, voffB);
            PG8_WAIT_V(6); PG8_BAR; PG8_MMA(1, 1, At, B1); PG8_BAR;
            PG8_LDB(B0, 1, 0); PG8_SCHED; PG8_LDA(At, 1, 0); PG8_STAGE(PG8_SA(0, 1), a2 + hstepA, voffA);
            PG8_WAIT_L(8); PG8_BAR; PG8_WAIT_L(0); PG8_MMA(0, 0, At, B0); PG8_BAR; PG8_SCHED;
            PG8_LDB(B1, 1, 1); PG8_STAGE(PG8_SB(1, 0), b3, voffB);
            PG8_BAR; PG8_WAIT_L(0); PG8_MMA(0, 1, At, B1); PG8_BAR;
            PG8_LDA(At, 1, 1); PG8_STAGE(PG8_SA(1, 0), a3, voffA);
            PG8_BAR; PG8_WAIT_L(0); PG8_MMA(1, 0, At, B0); PG8_BAR; PG8_SCHED;
            PG8_STAGE(PG8_SB(1, 1), b3 + hstepB, voffB);
            PG8_WAIT_V(6); PG8_BAR; PG8_MMA(1, 1, At, B1); PG8_BAR;
        }
#if DIAG == 3
        const unsigned long long tk1 = __builtin_amdgcn_s_memrealtime();
#endif
        if (MODE == 1) {
            const int row0 = cur.pm * BM + wr * 64 + fr, col0 = cur.pn * BM + wc * 32 + 8 * fq;
            const bool isV = (cur.pn >= 4 && cur.pn < 8);
            auto store_tile = [&](auto stats_tag) __attribute__((always_inline)) {
                constexpr bool STATS = decltype(stats_tag)::value;
#pragma unroll
                for (int ai = 0; ai < 2; ++ai)
#pragma unroll
                    for (int m = 0; m < 4; ++m) {
                        const int row = row0 + ai * HALF + m * 16;
                        bf16_t* rowp = p.h + (size_t)row * HS + col0;
                        float s = 0.f, ss = 0.f;
#pragma unroll
                        for (int bj = 0; bj < 2; ++bj) {
                            const f32x4 v0 = acc[ai][bj][m][0], v1 = acc[ai][bj][m][1];
                            u32x4 w; w.x = cvt_pk_bf16(v0[0], v0[1]); w.y = cvt_pk_bf16(v0[2], v0[3]); w.z = cvt_pk_bf16(v1[0], v1[1]); w.w = cvt_pk_bf16(v1[2], v1[3]);
                            __builtin_nontemporal_store(w, (u32x4*)(rowp + bj * HALF));
                            if (STATS) {
                                s += (v0[0] + v0[1]) + (v0[2] + v0[3]) + (v1[0] + v1[1]) + (v1[2] + v1[3]);
                                ss += v0[0] * v0[0] + v0[1] * v0[1] + v0[2] * v0[2] + v0[3] * v0[3] + v1[0] * v1[0] + v1[1] * v1[1] + v1[2] * v1[2] + v1[3] * v1[3];
                            }
                        }
                        if (STATS) {
                            s += __shfl_xor(s, 16); ss += __shfl_xor(ss, 16);
                            s += __shfl_xor(s, 32); ss += __shfl_xor(ss, 32);
                            if (fq == 0) { f32x2 o; o.x = s; o.y = ss; *(f32x2*)(p.stats + ((size_t)row * 16 + (cur.pn - 4) * 4 + wc) * 2) = o; }
                        }
                    }
            };
            if (isV) store_tile(BoolTag<true>{}); else store_tile(BoolTag<false>{});
        } else if (!FUSE) {
            const int row0 = cur.pm * BM + wr * 64 + fr, col0 = cur.pn * BM + wc * 32 + 4 * fq;
#pragma unroll
            for (int ai = 0; ai < 2; ++ai)
#pragma unroll
                for (int m = 0; m < 4; ++m) {
                    const int row = row0 + ai * HALF + m * 16;
                    const float* xr = xrow_ptr(p, row) + col0;
                    float* orow = p.out + (size_t)row * DM + col0;
                    float ss = 0.f;
#pragma unroll
                    for (int bj = 0; bj < 2; ++bj)
#pragma unroll
                        for (int n = 0; n < 2; ++n) {
                            const f32x4 xv = __builtin_nontemporal_load((const f32x4*)(xr + bj * HALF + n * 16));
                            const f32x4 v = acc[ai][bj][m][n] + xv;
                            *(f32x4*)(orow + bj * HALF + n * 16) = v;
                            ss += v[0] * v[0] + v[1] * v[1] + v[2] * v[2] + v[3] * v[3];
                        }
                    ss += __shfl_xor(ss, 16); ss += __shfl_xor(ss, 32);
                    if (fq == 0) p.fpart[(size_t)row * 16 + cur.pn * 4 + wc] = ss;
                }
        } else {
            PG8_SCHED; if (wr == 0) PG8_BAR; PG8_SCHED;
            const int row0 = cur.pm * BM + wr * 64 + fr, col0 = cur.pn * BM + wc * 32 + 4 * fq;
#pragma unroll
            for (int ai = 0; ai < 2; ++ai)
#pragma unroll
                for (int m = 0; m < 4; ++m) {
                    const int row = row0 + ai * HALF + m * 16;
                    const float* xr = xrow_ptr(p, row) + col0;
                    float ss = 0.f;
#pragma unroll
                    for (int bj = 0; bj < 2; ++bj)
#pragma unroll
                        for (int n = 0; n < 2; ++n) {
                            const f32x4 xv = __builtin_nontemporal_load((const f32x4*)(xr + bj * HALF + n * 16));
                            const f32x4 v = acc[ai][bj][m][n] + xv;
                            acc[ai][bj][m][n] = v;
                            ss += v[0] * v[0] + v[1] * v[1] + v[2] * v[2] + v[3] * v[3];
                        }
                    ss += __shfl_xor(ss, 16); ss += __shfl_xor(ss, 32);
                    if (fq == 0) __hip_atomic_store(p.fpart + (size_t)row * 16 + cur.pn * 4 + wc, ss, __ATOMIC_RELAXED, __HIP_MEMORY_SCOPE_AGENT);
                }
            asm volatile("s_waitcnt vmcnt(0)" ::: "memory");
            unsigned* pc = p.bar + XCD_BAR_WORDS_C + cur.pm * 2 + wr;
            if (lane == 0) __hip_atomic_fetch_add(pc, 1u, __ATOMIC_RELAXED, __HIP_MEMORY_SCOPE_AGENT);
            { unsigned sp = 0; while (__hip_atomic_load(pc, __ATOMIC_RELAXED, __HIP_MEMORY_SCOPE_AGENT) < 16u) { __builtin_amdgcn_s_sleep(2); if (++sp > (1u << 20)) break; } }
            asm volatile("" ::: "memory");
            f32x4 nw[2][2];
#pragma unroll
            for (int bj = 0; bj < 2; ++bj)
#pragma unroll
                for (int n = 0; n < 2; ++n) nw[bj][n] = *(const f32x4*)(p.norm_f_w + col0 + bj * HALF + n * 16);
#pragma unroll
            for (int ai = 0; ai < 2; ++ai)
#pragma unroll
                for (int m = 0; m < 4; ++m) {
                    const int row = row0 + ai * HALF + m * 16;
                    unsigned long long* fp = (unsigned long long*)(p.fpart + (size_t)row * 16 + fq * 4);
                    const unsigned long long a = __hip_atomic_load(fp, __ATOMIC_RELAXED, __HIP_MEMORY_SCOPE_AGENT), b = __hip_atomic_load(fp + 1, __ATOMIC_RELAXED, __HIP_MEMORY_SCOPE_AGENT);
                    float s = (__uint_as_float((unsigned)a) + __uint_as_float((unsigned)(a >> 32))) + (__uint_as_float((unsigned)b) + __uint_as_float((unsigned)(b >> 32)));
                    s += __shfl_xor(s, 16); s += __shfl_xor(s, 32);
                    const float rs = rsqrtf(s * (1.f / 1024.f) + EPS);
                    float* orow = p.out + (size_t)row * DM + col0;
#pragma unroll
                    for (int bj = 0; bj < 2; ++bj)
#pragma unroll
                        for (int n = 0; n < 2; ++n) __builtin_nontemporal_store(acc[ai][bj][m][n] * rs * nw[bj][n], (f32x4*)(orow + bj * HALF + n * 16));
                }
            PG8_SCHED; if (wr == 1) PG8_BAR; PG8_SCHED;
        }
#if DIAG == 3
        if (MODE == DIAG_A && !SINGLE && blockIdx.x == 0 && tid == 0) { const unsigned long long tk2 = __builtin_amdgcn_s_memrealtime(); atomicAdd(p.ctr + 40, (unsigned)(tk1 - tk0)); atomicAdd(p.ctr + 41, (unsigned)(tk2 - tk1)); }
#endif
        if (!has_next) break;
#pragma unroll
        for (int a = 0; a < 2; ++a)
#pragma unroll
            for (int b = 0; b < 2; ++b)
#pragma unroll
                for (int m = 0; m < 4; ++m)
#pragma unroll
                    for (int n = 0; n < 2; ++n) acc[a][b][m][n] = (f32x4){0.f, 0.f, 0.f, 0.f};
        cur = nxt; cA = nA; cB = nB; ++ui;
    }
    PG8_WAIT_V(0);
    if (wr == 0) PG8_BAR;
    PG8_BAR;
#undef AK
#undef PG8_SA
#undef PG8_SB
#undef PG8_STAGE
#undef PG8_LDA
#undef PG8_LDB
#undef PG8_MMA
#undef PG8_WAIT_V
#undef PG8_WAIT_L
#undef PG8_BAR
#undef PG8_SCHED
}

__device__ __forceinline__ void dt_panel(const Params& p, LAS unsigned char* lds, int pm) {
    const int tid = threadIdx.x, lane = tid & 63, wid = tid >> 6, fr = lane & 15, fq = lane >> 4;
    constexpr int D_WS = 69632;
    __syncthreads();
    for (int i = tid; i < 16 * 128; i += 512) {
        const int r = i >> 7, cq = i & 127;
        *(LAS bf16x8*)(lds + D_WS + (r * 1032 + cq * 8) * 2) = *(const bf16x8*)(p.WdtT + (size_t)r * 1024 + cq * 8);
    }
    const int rr = tid >> 4, cc = (tid & 15) * 8;
    const bf16_t* ag = p.xn + (size_t)(pm * 256 + rr) * DM + cc;
    bf16x8 q[8];
#pragma unroll
    for (int i = 0; i < 8; ++i) q[i] = *(const bf16x8*)(ag + (size_t)(32 * i) * DM);
    f32x4 d0 = (f32x4){0.f, 0.f, 0.f, 0.f}, d1 = (f32x4){0.f, 0.f, 0.f, 0.f};
#pragma unroll 1
    for (int kc = 0; kc < 8; ++kc) {
        __syncthreads();
#pragma unroll
        for (int i = 0; i < 8; ++i) *(LAS bf16x8*)(lds + ((rr + 32 * i) * 136 + cc) * 2) = q[i];
        if (kc + 1 < 8) {
#pragma unroll
            for (int i = 0; i < 8; ++i) q[i] = *(const bf16x8*)(ag + (size_t)(32 * i) * DM + (kc + 1) * 128);
        }
        __syncthreads();
#pragma unroll
        for (int kk = 0; kk < 4; ++kk) {
            const bf16x8 b = *(const LAS bf16x8*)(lds + D_WS + (fr * 1032 + kc * 128 + kk * 32 + fq * 8) * 2);
            const bf16x8 a0 = *(const LAS bf16x8*)(lds + ((wid * 32 + fr) * 136 + kk * 32 + fq * 8) * 2);
            const bf16x8 a1 = *(const LAS bf16x8*)(lds + ((wid * 32 + 16 + fr) * 136 + kk * 32 + fq * 8) * 2);
            d0 = MFMA16(a0, b, d0);
            d1 = MFMA16(a1, b, d1);
        }
    }
    const int rb = pm * 256 + wid * 32;
#pragma unroll
    for (int j = 0; j < 4; ++j) {
        p.dtraw[(size_t)(rb + fq * 4 + j) * 16 + fr] = d0[j];
        p.dtraw[(size_t)(rb + 16 + fq * 4 + j) * 16 + fr] = d1[j];
    }
}
__device__ __forceinline__ void phase1_tail(const Params& p, LAS unsigned char* lds) {
    const int G = gridDim.x, rem = 2992 % G;
    const int first = rem ? rem : 0, nidle = G - first;
    if ((int)blockIdx.x >= first) for (int pm = (int)blockIdx.x - first; pm < 136; pm += nidle) dt_panel(p, lds, pm);
}

__device__ __forceinline__ void unpack8(const bf16x8 v, float* f) {
    const u32x4 w = __builtin_bit_cast(u32x4, v);
    f[0] = bf_lo(w.x); f[1] = bf_hi(w.x); f[2] = bf_lo(w.y); f[3] = bf_hi(w.y); f[4] = bf_lo(w.z); f[5] = bf_hi(w.z); f[6] = bf_lo(w.w); f[7] = bf_hi(w.w);
}

struct ConvRaw { bf16x8 r[11]; };
constexpr int L_CW = 4096;

__device__ __forceinline__ void conv_load(const Params& p, int ci, int third, ConvRaw& R) {
    const int u = third * 512 + (int)threadIdx.x, cg_ = u % 192, rb = u / 192, ch0 = cg_ * 8;
    const bool halo = rb > 0 || (ci < 512 && (ci & 63) != 0);
    const bf16_t* hx = p.h + (size_t)(ci * 64 + rb * 8) * HS + 4096 + ch0;
    if (halo) {
#pragma unroll
        for (int k = 0; k < 3; ++k) R.r[k] = *(const bf16x8*)(hx + (long)(k - 3) * HS);
    }
#pragma unroll
    for (int k = 3; k < 11; ++k) R.r[k] = __builtin_nontemporal_load((const bf16x8*)(hx + (long)(k - 3) * HS));
}

__device__ __forceinline__ void conv_compute(const Params& p, LAS unsigned char* lds, int ci, int third, const ConvRaw& R) {
    const int tid = threadIdx.x;
    const int u = third * 512 + tid, cg_ = u % 192, rb = u / 192, ch0 = cg_ * 8;
    const int r0 = ci * 64;
    const bool prompt = ci < 512;
    const int c = ci & 63;
    float w0[8], w1[8], w2[8], w3[8], bb[8];
    {
        const LAS float* cw = (const LAS float*)(lds + L_CW) + ch0;
#pragma unroll
        for (int q = 0; q < 2; ++q) {
            const f32x4 a0 = *(const LAS f32x4*)(cw + 0 * XS + q * 4), a1 = *(const LAS f32x4*)(cw + 1 * XS + q * 4);
            const f32x4 a2 = *(const LAS f32x4*)(cw + 2 * XS + q * 4), a3 = *(const LAS f32x4*)(cw + 3 * XS + q * 4);
            const f32x4 b4 = *(const LAS f32x4*)(cw + 4 * XS + q * 4);
#pragma unroll
            for (int j = 0; j < 4; ++j) { w0[q * 4 + j] = a0[j]; w1[q * 4 + j] = a1[j]; w2[q * 4 + j] = a2[j]; w3[q * 4 + j] = a3[j]; bb[q * 4 + j] = b4[j]; }
        }
    }
    float x0[8], x1[8], x2[8];
    if (rb > 0 || (prompt && c != 0)) {
        unpack8(R.r[0], x0); unpack8(R.r[1], x1); unpack8(R.r[2], x2);
    } else if (prompt) {
#pragma unroll
        for (int j = 0; j < 8; ++j) { x0[j] = 0.f; x1[j] = 0.f; x2[j] = 0.f; }
    } else {
        const float* sc = p.state_conv + (size_t)(ci - 512) * 3 * XS + ch0;
#pragma unroll
        for (int q = 0; q < 2; ++q) {
            const f32x4 a0 = *(const f32x4*)(sc + 0 * XS + q * 4), a1 = *(const f32x4*)(sc + 1 * XS + q * 4), a2 = *(const f32x4*)(sc + 2 * XS + q * 4);
#pragma unroll
            for (int j = 0; j < 4; ++j) { x0[q * 4 + j] = a0[j]; x1[q * 4 + j] = a1[j]; x2[q * 4 + j] = a2[j]; }
        }
    }
    unsigned ob[8][4];
#pragma unroll
    for (int rr = 0; rr < 8; ++rr) {
        float cur[8], o[8];
        unpack8(R.r[3 + rr], cur);
#pragma unroll
        for (int j = 0; j < 8; ++j) {
            const float y = bb[j] + w0[j] * x0[j] + w1[j] * x1[j] + w2[j] * x2[j] + w3[j] * cur[j];
            o[j] = silu_f(y);
            x0[j] = x1[j]; x1[j] = x2[j]; x2[j] = cur[j];
        }
        u32x4 w; w.x = cvt_pk_bf16(o[0], o[1]); w.y = cvt_pk_bf16(o[2], o[3]); w.z = cvt_pk_bf16(o[4], o[5]); w.w = cvt_pk_bf16(o[6], o[7]);
        *(u32x4*)(p.xbc + (size_t)(r0 + rb * 8 + rr) * XSB + ch0) = w;
        ob[rr][0] = w.x; ob[rr][1] = w.y; ob[rr][2] = w.z; ob[rr][3] = w.w;
    }
    if (ch0 >= 1024 && ch0 < 1280) {
        const int g = (ch0 - 1024) >> 7, n0 = (ch0 - 1024) & 127;
        bf16_t* bt = p.BT + ((size_t)(ci * 2 + g) * 128 + n0) * 64 + rb * 8;
#pragma unroll
        for (int j = 0; j < 8; ++j) {
            unsigned e[8];
#pragma unroll
            for (int rr = 0; rr < 8; ++rr) e[rr] = (j & 1) ? (ob[rr][j >> 1] >> 16) : (ob[rr][j >> 1] & 0xffffu);
            u32x4 w; w.x = e[0] | (e[1] << 16); w.y = e[2] | (e[3] << 16); w.z = e[4] | (e[5] << 16); w.w = e[6] | (e[7] << 16);
            *(u32x4*)(bt + (size_t)j * 64) = w;
        }
    }
    if (rb == 7 && (!prompt || c == 63)) {
        float* dst = prompt ? p.out + O_CONVP + (size_t)(ci >> 6) * 3 * XS + ch0 : p.out + O_CONVS + (size_t)(ci - 512) * 3 * XS + ch0;
#pragma unroll
        for (int q = 0; q < 2; ++q) {
            *(f32x4*)(dst + 0 * XS + q * 4) = (f32x4){x0[q * 4], x0[q * 4 + 1], x0[q * 4 + 2], x0[q * 4 + 3]};
            *(f32x4*)(dst + 1 * XS + q * 4) = (f32x4){x1[q * 4], x1[q * 4 + 1], x1[q * 4 + 2], x1[q * 4 + 3]};
            *(f32x4*)(dst + 2 * XS + q * 4) = (f32x4){x2[q * 4], x2[q * 4 + 1], x2[q * 4 + 2], x2[q * 4 + 3]};
        }
    }
}

__device__ __forceinline__ void dt_item(const Params& p, LAS unsigned char* lds, int ci) {
    const int tid = threadIdx.x, lane = tid & 63, wid = tid >> 6, fr = lane & 15, fq = lane >> 4;
    const int r0 = ci * 64;
    LAS float* sDt = (LAS float*)lds;
    __syncthreads();
#pragma unroll
    for (int i = 0; i < 2; ++i) {
        const int idx = tid + 512 * i, l = idx >> 4, hd = idx & 15;
        const float xx = p.dtraw[(size_t)(r0 + l) * 16 + hd] + p.dt_bias[hd];
        sDt[hd * 64 + l] = xx > 20.f ? xx : log1pf(__expf(xx));
    }
    __syncthreads();
#pragma unroll
    for (int hh = 0; hh < 2; ++hh) {
        const int hd = wid + hh * 8;
        const float dtv = sDt[hd * 64 + lane];
        const float a = -__expf(p.a_log[hd]);
        float v = dtv * a;
#pragma unroll
        for (int o = 1; o < 64; o <<= 1) { const float t = __shfl_up(v, o); if (lane >= o) v += t; }
        p.dtT[((size_t)ci * 16 + hd) * 64 + lane] = dtv;
        p.acT[((size_t)ci * 16 + hd) * 64 + lane] = v;
    }
}

__device__ __forceinline__ void phase2a(const Params& p, LAS unsigned char* lds) {
    const int G = gridDim.x, blk = blockIdx.x;
    for (int i = threadIdx.x; i < 5 * XS; i += 512) ((LAS float*)(lds + L_CW))[i] = i < 4 * XS ? p.conv_w[i] : p.conv_b[i - 4 * XS];
    __syncthreads();
    ConvRaw A, B;
    if (blk < 1632) conv_load(p, blk / 3, blk % 3, A);
#pragma unroll 1
    for (int it = blk; it < 1632; it += 2 * G) {
        const int it1 = it + G, it2 = it + 2 * G;
        if (it1 < 1632) conv_load(p, it1 / 3, it1 % 3, B);
        conv_compute(p, lds, it / 3, it % 3, A);
        if (it2 < 1632) conv_load(p, it2 / 3, it2 % 3, A);
        if (it1 < 1632) conv_compute(p, lds, it1 / 3, it1 % 3, B);
    }
    for (int it = G - 1 - blk; it < 544; it += G) dt_item(p, lds, it);
}

#define LDS_BARRIER() do { asm volatile("s_waitcnt lgkmcnt(0)" ::: "memory"); __builtin_amdgcn_s_barrier(); asm volatile("" ::: "memory"); } while (0)
__device__ __forceinline__ void item_done(const Params& p) {
    asm volatile("s_waitcnt vmcnt(0)" ::: "memory");
    __syncthreads();
    if (threadIdx.x == 0) __hip_atomic_fetch_add(p.ctr + 1, 1u, __ATOMIC_RELAXED, __HIP_MEMORY_SCOPE_AGENT);
}
struct SsdStage { bf16x8 B[2], C[2], BT[2], z, xc; float dt, ac; };
constexpr int L_BS = 0, L_CS = 17408, L_BTS = 34816, L_ZS = 53248, L_XL = 62464, L_XT = 71680, L_XDD = 80896, L_MX = 90112, L_HL = 99328, L_DTS = 116736, L_ACS = 116992;

__device__ __forceinline__ void ssd_stage_load(const Params& p, int r0, int hd, int g, int tid, SsdStage& s) {
    const int lane = tid & 63, wid = tid >> 6, ci = r0 >> 6;
    const bf16_t* xb = p.xbc + (size_t)r0 * XSB;
    const int rr = tid >> 4, cc = (tid & 15) * 8;
    s.B[0] = __builtin_nontemporal_load((const bf16x8*)(xb + (size_t)rr * XSB + 1024 + g * 128 + cc));
    s.B[1] = __builtin_nontemporal_load((const bf16x8*)(xb + (size_t)(rr + 32) * XSB + 1024 + g * 128 + cc));
    s.C[0] = __builtin_nontemporal_load((const bf16x8*)(xb + (size_t)rr * XSB + 1280 + g * 128 + cc));
    s.C[1] = __builtin_nontemporal_load((const bf16x8*)(xb + (size_t)(rr + 32) * XSB + 1280 + g * 128 + cc));
    const bf16_t* bt = p.BT + (size_t)(ci * 2 + g) * 8192;
    s.BT[0] = __builtin_nontemporal_load((const bf16x8*)(bt + tid * 8));
    s.BT[1] = __builtin_nontemporal_load((const bf16x8*)(bt + 4096 + tid * 8));
    s.z = __builtin_nontemporal_load((const bf16x8*)(p.h + (size_t)(r0 + (tid >> 3)) * HS + 3072 + hd * 64 + (tid & 7) * 8));
    s.xc = *(const bf16x8*)(xb + (size_t)lane * XSB + hd * 64 + wid * 8);
    s.dt = p.dtT[((size_t)ci * 16 + hd) * 64 + lane];
    s.ac = p.acT[((size_t)ci * 16 + hd) * 64 + lane];
}

__device__ __forceinline__ void ssd_item(const Params& p, LAS unsigned char* lds, int seq, int hd) {
    const int tid = threadIdx.x, lane = tid & 63, wid = __builtin_amdgcn_readfirstlane(tid >> 6), fr = lane & 15, fq = lane >> 4, lt = wid >> 1;
    const bool prompt = seq < 8;
    const int nch = prompt ? 64 : 1;
    const int rbase = prompt ? seq * 4096 : T_PROMPT + (seq - 8) * 64;
    const int g = hd >> 3;
    const float Dsk = p.d_skip[hd];
    f32x4 hT[4];
    float* hout = prompt ? p.out + O_SSMP + (size_t)(seq * 16 + hd) * 8192 : p.out + O_SSMS + (size_t)((seq - 8) * 16 + hd) * 8192;
    if (prompt) {
#pragma unroll
        for (int pt = 0; pt < 4; ++pt) hT[pt] = (f32x4){0.f, 0.f, 0.f, 0.f};
    } else {
        const float* h0 = p.state_ssm + (size_t)((seq - 8) * 16 + hd) * 8192;
#pragma unroll
        for (int pt = 0; pt < 4; ++pt) hT[pt] = *(const f32x4*)(h0 + (size_t)(pt * 16 + fr) * 128 + wid * 16 + fq * 4);
    }
    LAS bf16_t* xT = (LAS bf16_t*)(lds + L_XT); LAS bf16_t* xdd = (LAS bf16_t*)(lds + L_XDD);
    LAS float* dts = (LAS float*)(lds + L_DTS); LAS float* acs = (LAS float*)(lds + L_ACS);
    SsdStage sA, sB;
    ssd_stage_load(p, rbase, hd, g, tid, sA);
    ssd_stage_load(p, nch > 1 ? rbase + 64 : rbase, hd, g, tid, sB);
    auto chunk_body = [&](const int c, SsdStage& s0) __attribute__((always_inline)) {
        const int r0 = rbase + c * 64;
        {
            const int rr = tid >> 4, cc = (tid & 15) * 8;
            *(LAS bf16x8*)(lds + L_BS + (rr * 136 + cc) * 2) = s0.B[0];
            *(LAS bf16x8*)(lds + L_BS + ((rr + 32) * 136 + cc) * 2) = s0.B[1];
            *(LAS bf16x8*)(lds + L_CS + (rr * 136 + cc) * 2) = s0.C[0];
            *(LAS bf16x8*)(lds + L_CS + ((rr + 32) * 136 + cc) * 2) = s0.C[1];
            *(LAS bf16x8*)(lds + L_BTS + ((tid >> 3) * 72 + (tid & 7) * 8) * 2) = s0.BT[0];
            *(LAS bf16x8*)(lds + L_BTS + (((tid >> 3) + 64) * 72 + (tid & 7) * 8) * 2) = s0.BT[1];
            *(LAS bf16x8*)(lds + L_ZS + ((tid >> 3) * 72 + (tid & 7) * 8) * 2) = s0.z;
            *(LAS bf16x8*)(lds + L_XL + (lane * 72 + wid * 8) * 2) = s0.xc;
            if (wid == 0) { dts[lane] = s0.dt; acs[lane] = s0.ac; }
            const float ac63 = __shfl(s0.ac, 63);
            const float decl = __expf(ac63 - s0.ac) * s0.dt;
            float xf[8]; unpack8(s0.xc, xf);
#pragma unroll
            for (int j = 0; j < 8; ++j) {
                xT[(wid * 8 + j) * 72 + lane] = (bf16_t)s0.xc[j];
                xdd[(wid * 8 + j) * 72 + lane] = (bf16_t)(cvt_pk_bf16(xf[j] * decl, 0.f) & 0xffffu);
            }
#pragma unroll
            for (int pt = 0; pt < 4; ++pt) {
                u32x2 w; w.x = cvt_pk_bf16(hT[pt][0], hT[pt][1]); w.y = cvt_pk_bf16(hT[pt][2], hT[pt][3]);
                *(LAS u32x2*)(lds + L_HL + ((pt * 16 + fr) * 136 + wid * 16 + fq * 4) * 2) = w;
            }
        }
        const bool sig = prompt && c >= 4 && (c & 3) == 0;
        if (sig) asm volatile("s_waitcnt vmcnt(0)" ::: "memory");
        if (c + 2 < nch) ssd_stage_load(p, r0 + 128, hd, g, tid, s0);
        LDS_BARRIER();
        if (sig && tid == 0) __hip_atomic_fetch_add(p.bar + PCNT_OFF + seq * 16 + (c >> 2) - 1, 1u, __ATOMIC_RELAXED, __HIP_MEMORY_SCOPE_AGENT);
        bf16x8 Cf[4];
#pragma unroll
        for (int kk = 0; kk < 4; ++kk) Cf[kk] = *(const LAS bf16x8*)(lds + L_CS + ((lt * 16 + fr) * 136 + kk * 32 + fq * 8) * 2);
        const float ac_l = acs[lt * 16 + fr];
        const float ac63u = acs[63];
        {
            const int lidx = lt * 16 + fr;
#pragma unroll
            for (int i = 0; i < 2; ++i) {
                const int st = (wid & 1) * 2 + i;
                f32x4 cb = (f32x4){0.f, 0.f, 0.f, 0.f};
#pragma unroll
                for (int kk = 0; kk < 4; ++kk) {
                    const bf16x8 Bf = *(const LAS bf16x8*)(lds + L_BS + ((st * 16 + fr) * 136 + kk * 32 + fq * 8) * 2);
                    cb = MFMA16(Bf, Cf[kk], cb);
                }
                const f32x4 ac_s = *(const LAS f32x4*)(acs + st * 16 + fq * 4);
                const f32x4 dt_s = *(const LAS f32x4*)(dts + st * 16 + fq * 4);
                float m[4];
#pragma unroll
                for (int j = 0; j < 4; ++j) {
                    const int s = st * 16 + fq * 4 + j;
                    const float diff = fminf(ac_l - ac_s[j], 0.f);
                    m[j] = (s <= lidx) ? cb[j] * __expf(diff) * dt_s[j] : 0.f;
                }
                u32x2 w; w.x = cvt_pk_bf16(m[0], m[1]); w.y = cvt_pk_bf16(m[2], m[3]);
                *(LAS u32x2*)(lds + L_MX + (lidx * 72 + st * 16 + fq * 4) * 2) = w;
            }
        }
        LDS_BARRIER();
        {
            const float el = __expf(ac_l);
            float ss = 0.f;
#pragma unroll
            for (int i = 0; i < 2; ++i) {
                const int pt = (wid & 1) * 2 + i;
                f32x4 yd = (f32x4){0.f, 0.f, 0.f, 0.f}, yo = (f32x4){0.f, 0.f, 0.f, 0.f};
#pragma unroll
                for (int kk = 0; kk < 2; ++kk) {
                    const bf16x8 A = *(const LAS bf16x8*)(lds + L_XT + ((pt * 16 + fr) * 72 + kk * 32 + fq * 8) * 2);
                    const bf16x8 Bo = *(const LAS bf16x8*)(lds + L_MX + ((lt * 16 + fr) * 72 + kk * 32 + fq * 8) * 2);
                    yd = MFMA16(A, Bo, yd);
                }
#pragma unroll
                for (int kk = 0; kk < 4; ++kk) {
                    const bf16x8 A = *(const LAS bf16x8*)(lds + L_HL + ((pt * 16 + fr) * 136 + kk * 32 + fq * 8) * 2);
                    yo = MFMA16(A, Cf[kk], yo);
                }
                const u32x2 xs = *(const LAS u32x2*)(lds + L_XL + ((lt * 16 + fr) * 72 + pt * 16 + fq * 4) * 2);
                const u32x2 zz = *(const LAS u32x2*)(lds + L_ZS + ((lt * 16 + fr) * 72 + pt * 16 + fq * 4) * 2);
                const float xv[4] = {bf_lo(xs.x), bf_hi(xs.x), bf_lo(xs.y), bf_hi(xs.y)};
                const float zv[4] = {bf_lo(zz.x), bf_hi(zz.x), bf_lo(zz.y), bf_hi(zz.y)};
                float yz[4];
#pragma unroll
                for (int j = 0; j < 4; ++j) { const float y = yd[j] + el * yo[j] + Dsk * xv[j]; yz[j] = y * silu_f(zv[j]); ss += yz[j] * yz[j]; }
                u32x2 w; w.x = cvt_pk_bf16(yz[0], yz[1]); w.y = cvt_pk_bf16(yz[2], yz[3]);
                bf16_t* yzp = p.h + (size_t)(r0 + lt * 16 + fr) * HS + 3072 + hd * 64 + pt * 16 + fq * 4;
                __hip_atomic_store((unsigned long long*)yzp, ((unsigned long long)w.y << 32) | w.x, __ATOMIC_RELAXED, __HIP_MEMORY_SCOPE_AGENT);
            }
            ss += __shfl_xor(ss, 16); ss += __shfl_xor(ss, 32);
            if (fq == 0) atomicAdd(p.ssq + r0 + lt * 16 + fr, ss);
            const float cd = __expf(ac63u);
            bf16x8 BTf[2];
#pragma unroll
            for (int kk = 0; kk < 2; ++kk) BTf[kk] = *(const LAS bf16x8*)(lds + L_BTS + ((wid * 16 + fr) * 72 + kk * 32 + fq * 8) * 2);
#pragma unroll
            for (int pt = 0; pt < 4; ++pt) {
                f32x4 acc = hT[pt] * cd;
#pragma unroll
                for (int kk = 0; kk < 2; ++kk) {
                    const bf16x8 Bo = *(const LAS bf16x8*)(lds + L_XDD + ((pt * 16 + fr) * 72 + kk * 32 + fq * 8) * 2);
                    acc = MFMA16(BTf[kk], Bo, acc);
                }
                hT[pt] = acc;
            }
        }
        LDS_BARRIER();
    };
#pragma unroll 1
    for (int c = 0; c < nch; c += 2) {
        chunk_body(c, sA);
        if (c + 1 < nch) chunk_body(c + 1, sB);
    }
#pragma unroll
    for (int pt = 0; pt < 4; ++pt) *(f32x4*)(hout + (size_t)(pt * 16 + fr) * 128 + wid * 16 + fq * 4) = hT[pt];
    if (!prompt) item_done(p);
    else {
        asm volatile("s_waitcnt vmcnt(0)" ::: "memory");
        __syncthreads();
        if (tid == 0) __hip_atomic_fetch_add(p.bar + PCNT_OFF + seq * 16 + 15, 1u, __ATOMIC_RELAXED, __HIP_MEMORY_SCOPE_AGENT);
    }
}

constexpr int G_VS = 0, G_WS = 34816, G_VNT = 69632, G_MU = 104448, G_RS = 104960;
__device__ __forceinline__ void gmlp_item(const Params& p, LAS unsigned char* lds, int item) {
    const int tid = threadIdx.x, lane = tid & 63, wid = __builtin_amdgcn_readfirstlane(tid >> 6), fr = lane & 15, fq = lane >> 4;
    const bool sample = item >= 2048;
    const int hd = item & 7;
    const int r0 = sample ? T_PROMPT + ((item - 2048) >> 3) * 128 : (item >> 3) * 128;
    LAS bf16_t* vnT = (LAS bf16_t*)(lds + G_VNT);
    LAS float* mus = (LAS float*)(lds + G_MU); LAS float* rss = (LAS float*)(lds + G_RS);
    const int wt = sample ? (wid & 3) : wid;
    const int kk0 = sample ? ((wid >> 2) * 2) : 0;
    const int nkk = sample ? 2 : (wid < 4 ? 2 : 4);
    const int rr = tid >> 4, cc = (tid & 15) * 8;
    bf16_t* hb = p.h + (size_t)(r0 + rr) * HS + hd * 128 + cc;
    bf16x8 vv[4], uu[4], gg[4], ww[4];
#pragma unroll
    for (int i = 0; i < 4; ++i) {
        vv[i] = __builtin_nontemporal_load((const bf16x8*)(hb + (size_t)i * 32 * HS + 1024));
        uu[i] = __builtin_nontemporal_load((const bf16x8*)(hb + (size_t)i * 32 * HS));
        gg[i] = __builtin_nontemporal_load((const bf16x8*)(hb + (size_t)i * 32 * HS + 2048));
        ww[i] = *(const bf16x8*)(p.Wm + ((size_t)hd * 128 + rr + 32 * i) * 128 + cc);
    }
    const f32x4 sp0 = *(const f32x4*)(p.stats + (size_t)r0 * 32 + tid * 4), sp1 = *(const f32x4*)(p.stats + (size_t)r0 * 32 + 2048 + tid * 4);
#pragma unroll
    for (int i = 0; i < 4; ++i) {
        *(LAS bf16x8*)(lds + G_VS + ((rr + 32 * i) * 136 + cc) * 2) = vv[i];
        *(LAS bf16x8*)(lds + G_WS + ((rr + 32 * i) * 136 + cc) * 2) = ww[i];
    }
    {
        float s0 = sp0[0] + sp0[2], q0 = sp0[1] + sp0[3], s1 = sp1[0] + sp1[2], q1 = sp1[1] + sp1[3];
#pragma unroll
        for (int o = 1; o < 8; o <<= 1) { s0 += __shfl_xor(s0, o); q0 += __shfl_xor(q0, o); s1 += __shfl_xor(s1, o); q1 += __shfl_xor(q1, o); }
        if ((tid & 7) == 0) {
            const float m0 = s0 * (1.f / 1024.f), m1 = s1 * (1.f / 1024.f);
            mus[tid >> 3] = m0; rss[tid >> 3] = rsqrtf(fmaxf(q0 * (1.f / 1024.f) - m0 * m0, 0.f) + EPS);
            mus[64 + (tid >> 3)] = m1; rss[64 + (tid >> 3)] = rsqrtf(fmaxf(q1 * (1.f / 1024.f) - m1 * m1, 0.f) + EPS);
        }
    }
    LDS_BARRIER();
#pragma unroll
    for (int dd = 0; dd < 2; ++dd) {
        const int dg = wid + 8 * dd;
        float lw[8], lb[8];
#pragma unroll
        for (int q = 0; q < 2; ++q) {
            const f32x4 a = *(const f32x4*)(p.ln_w + hd * 128 + dg * 8 + q * 4), b = *(const f32x4*)(p.ln_b + hd * 128 + dg * 8 + q * 4);
#pragma unroll
            for (int j = 0; j < 4; ++j) { lw[q * 4 + j] = a[j]; lb[q * 4 + j] = b[j]; }
        }
        const int slot0 = (dg >> 2) * 32 + (dg & 3) * 4;
#pragma unroll
        for (int q = 0; q < 2; ++q) {
            const int s = lane + 64 * q;
            const float mu = mus[s], rs = rss[s];
            float v[8]; unpack8(*(const LAS bf16x8*)(lds + G_VS + (s * 136 + dg * 8) * 2), v);
#pragma unroll
            for (int j = 0; j < 8; ++j) v[j] = (v[j] - mu) * rs * lw[j] + lb[j];
#pragma unroll
            for (int j = 0; j < 8; ++j) vnT[(slot0 + (j >> 2) * 16 + (j & 3)) * 136 + s] = (bf16_t)(cvt_pk_bf16(v[j], 0.f) & 0xffffu);
            if (sample) {
                float* vo = p.out + O_VS + (size_t)(r0 + s - T_PROMPT) * 1024 + hd * 128 + dg * 8;
                *(f32x4*)(vo) = (f32x4){v[0], v[1], v[2], v[3]};
                *(f32x4*)(vo + 4) = (f32x4){v[4], v[5], v[6], v[7]};
            }
        }
    }
    LDS_BARRIER();
    {
        bf16x8 Wf[4];
#pragma unroll
        for (int kk = 0; kk < 4; ++kk) Wf[kk] = *(const LAS bf16x8*)(lds + G_WS + ((wt * 16 + fr) * 136 + (kk < nkk ? kk : 0) * 32 + fq * 8) * 2);
        const float bias = p.gbs[hd * 128 + wt * 16 + fr];
#pragma unroll
        for (int q = 0; q < 4; ++q) {
#pragma unroll
            for (int hf = 0; hf < 2; ++hf) {
                f32x4 acc = (f32x4){0.f, 0.f, 0.f, 0.f};
#pragma unroll
                for (int kk = 0; kk < 4; ++kk) {
                    if (kk < nkk) {
                        const bf16x8 A = *(const LAS bf16x8*)(lds + G_VNT + ((q * 32 + hf * 16 + fr) * 136 + (kk0 + kk) * 32 + fq * 8) * 2);
                        acc = MFMA16(A, Wf[kk], acc);
                    }
                }
                u32x2 w; w.x = cvt_pk_bf16(acc[0] + bias, acc[1] + bias); w.y = cvt_pk_bf16(acc[2] + bias, acc[3] + bias);
                *(LAS u32x2*)(lds + G_VS + ((wid * 16 + fr) * 136 + q * 32 + fq * 8 + hf * 4) * 2) = w;
            }
        }
    }
    LDS_BARRIER();
#pragma unroll
    for (int i = 0; i < 4; ++i) {
        float mv[8], uv[8], gv[8], o[8];
        unpack8(*(const LAS bf16x8*)(lds + G_VS + ((rr + 32 * i) * 136 + cc) * 2), mv);
        unpack8(uu[i], uv); unpack8(gg[i], gv);
#pragma unroll
        for (int j = 0; j < 8; ++j) o[j] = uv[j] * mv[j] * silu_f(gv[j]);
        u32x4 w; w.x = cvt_pk_bf16(o[0], o[1]); w.y = cvt_pk_bf16(o[2], o[3]); w.z = cvt_pk_bf16(o[4], o[5]); w.w = cvt_pk_bf16(o[6], o[7]);
        __hip_atomic_store((unsigned long long*)(hb + (size_t)i * 32 * HS), ((unsigned long long)w.y << 32) | w.x, __ATOMIC_RELAXED, __HIP_MEMORY_SCOPE_AGENT);
        __hip_atomic_store((unsigned long long*)(hb + (size_t)i * 32 * HS + 4), ((unsigned long long)w.w << 32) | w.z, __ATOMIC_RELAXED, __HIP_MEMORY_SCOPE_AGENT);
    }
    if (sample) item_done(p);
    else {
        asm volatile("s_waitcnt vmcnt(0)" ::: "memory");
        __syncthreads();
        const int c128 = item >> 3;
        if (tid == 0) __hip_atomic_fetch_add(p.bar + PCNT_OFF + (c128 >> 5) * 16 + ((c128 & 31) >> 1), 1u, __ATOMIC_RELAXED, __HIP_MEMORY_SCOPE_AGENT);
    }
}

__device__ __forceinline__ void phase2b(const Params& p, LAS unsigned char* lds) {
    LAS int* sItem = (LAS int*)(lds + LDS_ITEM_OFF);
    int nxt = 0;
    if (threadIdx.x == 0) nxt = (int)atomicAdd(p.ctr, 1u);
    for (;;) {
        __syncthreads();
        if (threadIdx.x == 0) *sItem = nxt;
        __syncthreads();
        const int it = *sItem;
        if (it >= 640) break;
        if (threadIdx.x == 0 && it >= 128) nxt = (int)atomicAdd(p.ctr, 1u);
        const int seq = it < 128 ? (it >> 4) : 8 + ((it - 128) >> 4);
        ssd_item(p, lds, seq, it & 15);
        if (threadIdx.x == 0 && it < 128) nxt = (int)atomicAdd(p.ctr, 1u);
    }
    if (threadIdx.x == 0) nxt = (int)atomicAdd(p.ctr + 3, 1u);
    for (;;) {
        __syncthreads();
        if (threadIdx.x == 0) *sItem = nxt;
        __syncthreads();
        const int it = *sItem;
        if (it >= 2176) break;
        if (threadIdx.x == 0) nxt = (int)atomicAdd(p.ctr + 3, 1u);
        gmlp_item(p, lds, it < 128 ? 2048 + it : it - 128);
    }
    for (;;) {
        __syncthreads();
        if (threadIdx.x == 0) *sItem = (int)atomicAdd(p.ctr + 2, 1u);
        __syncthreads();
        const int u = *sItem;
        if (u >= 544) break;
        int pm, pn = u & 3;
        if (u < 32) pm = 128 + (u >> 2);
        else { const int v = u - 32; pm = ((v & 31) >> 2) * 16 + (v >> 5); }
        if (threadIdx.x == 0) {
            unsigned* cnt = u < 32 ? p.ctr + 1 : p.bar + PCNT_OFF + pm;
            const unsigned need = u < 32 ? 640u : 32u;
            unsigned sp = 0;
            while (__hip_atomic_load(cnt, __ATOMIC_RELAXED, __HIP_MEMORY_SCOPE_AGENT) < need) { __builtin_amdgcn_s_sleep(8); if (++sp > (1u << 22)) break; }
            __builtin_amdgcn_fence(__ATOMIC_ACQUIRE, "agent");
            asm volatile("s_waitcnt vmcnt(0)" ::: "memory");
        }
        __syncthreads();
        gemm_phase<2, true, true>(p, lds, pm, pn);
    }
}

__device__ __forceinline__ void phase4(const Params& p, int first_row) {
    const int tid = threadIdx.x, lane = tid & 63, wid = tid >> 6;
    const int G = gridDim.x;
    f32x4 nw[4];
#pragma unroll
    for (int i = 0; i < 4; ++i) nw[i] = *(const f32x4*)(p.norm_f_w + i * 256 + lane * 4);
    constexpr int RP = 1;
    for (int row0 = first_row + blockIdx.x * 8 + wid; row0 < T_ALL; row0 += G * 8 * RP) {
        f32x4 v[RP][4]; f32x4 fv[RP][4];
#pragma unroll
        for (int r = 0; r < RP; ++r) {
            const int row = row0 + r * G * 8;
            if (row < T_ALL) {
                const float* o = p.out + (size_t)row * DM;
                const float* fp = p.fpart + (size_t)row * 16;
#pragma unroll
                for (int i = 0; i < 4; ++i) { v[r][i] = *(const f32x4*)(o + i * 256 + lane * 4); fv[r][i] = *(const f32x4*)(fp + i * 4); }
            }
        }
#pragma unroll
        for (int r = 0; r < RP; ++r) {
            const int row = row0 + r * G * 8;
            if (row < T_ALL) {
                float ss = 0.f;
#pragma unroll
                for (int k = 0; k < 4; ++k) ss += (fv[r][k][0] + fv[r][k][1]) + (fv[r][k][2] + fv[r][k][3]);
                const float rs = rsqrtf(ss * (1.f / 1024.f) + EPS);
                float* o = p.out + (size_t)row * DM;
#pragma unroll
                for (int i = 0; i < 4; ++i) *(f32x4*)(o + i * 256 + lane * 4) = v[r][i] * rs * nw[i];
            }
        }
    }
}


#define XB_TMO      128
#define XB_XCNT(j)  (256  + 64 * (j))
#define XB_XSUB(j)  (1280 + 64 * (j))
#define XB_XGEN(j)  (2304 + 64 * (j))
#define XB_TOP      3328
#define XB_TOPGEN   3392
#define XCD_BAR_WORDS 3456
#define XB_SPIN_CAP (1u << 18)
__device__ __forceinline__ unsigned xb_ld(unsigned* p)              { return __hip_atomic_load(p, __ATOMIC_RELAXED, __HIP_MEMORY_SCOPE_AGENT); }
__device__ __forceinline__ unsigned xb_add(unsigned* p, unsigned v) { return __hip_atomic_fetch_add(p, v, __ATOMIC_RELAXED, __HIP_MEMORY_SCOPE_AGENT); }
__device__ __forceinline__ unsigned xb_xcc_id() { return (unsigned)__builtin_amdgcn_s_getreg((3 << 11) | 20) & 0xFu; }
#define XB_SPIN(cond, bar) do { unsigned _sp = 0; while (cond) { __builtin_amdgcn_s_sleep(1); \
    if ((++_sp & 255u) == 0u) { if (xb_ld(&(bar)[XB_TMO])) break; if (_sp > XB_SPIN_CAP) { atomicAdd(&(bar)[XB_TMO], 1u); break; } } } } while (0)
struct XcdBarrier { unsigned* bar; unsigned x; volatile LAS unsigned* st; };
__device__ __forceinline__ XcdBarrier xcd_barrier_post(unsigned* bar, volatile LAS unsigned* st) {
    XcdBarrier b; b.bar = bar; b.x = xb_xcc_id(); b.st = st;
    if (threadIdx.x == 0) (void)xb_add(&bar[XB_XCNT(b.x)], 1u);
    return b;
}
__device__ __forceinline__ void xcd_barrier_complete(unsigned* bar, unsigned x, unsigned& nloc, unsigned& nx) {
    const unsigned G = gridDim.x * gridDim.y * gridDim.z;
    unsigned sum, cnt, mine, sp = 0u;
    for (;;) {
        sum = 0u; cnt = 0u; mine = 0u;
#pragma unroll
        for (unsigned j = 0; j < 16; ++j) { const unsigned c = xb_ld(&bar[XB_XCNT(j)]); sum += c; cnt += (c > 0u) ? 1u : 0u; mine = (j == x) ? c : mine; }
        if (sum == G) break;
        __builtin_amdgcn_s_sleep(1);
        if ((++sp & 255u) == 0u) { if (xb_ld(&bar[XB_TMO])) break; if (sp > XB_SPIN_CAP) { atomicAdd(&bar[XB_TMO], 1u); break; } }
    }
    nloc = mine > 0u ? mine : 1u; nx = cnt > 0u ? cnt : 1u;
}
__device__ __forceinline__ void xcd_barrier(const XcdBarrier& b) {
    asm volatile("s_waitcnt vmcnt(0)" ::: "memory");
    __syncthreads();
    if (threadIdx.x == 0) {
        unsigned* bar = b.bar;
        __builtin_amdgcn_s_waitcnt(0);
        unsigned nloc = b.st[0], nx = b.st[1];
        if (nloc == 0u) { xcd_barrier_complete(bar, b.x, nloc, nx); b.st[0] = nloc; b.st[1] = nx; }
        const unsigned old = xb_add(&bar[XB_XSUB(b.x)], 1u);
        const unsigned gen = old / nloc;
        if (old + 1u == (gen + 1u) * nloc) {
            __builtin_amdgcn_fence(__ATOMIC_RELEASE, "agent");
            asm volatile("s_waitcnt vmcnt(0)" ::: "memory");
            const unsigned og = xb_add(&bar[XB_TOP], 1u);
            const unsigned tg = og / nx;
            if (og + 1u == (tg + 1u) * nx) xb_add(&bar[XB_TOPGEN], 1u);
            else XB_SPIN(xb_ld(&bar[XB_TOPGEN]) == tg, bar);
            __builtin_amdgcn_fence(__ATOMIC_ACQUIRE, "agent");
            xb_add(&bar[XB_XGEN(b.x)], 1u);
            asm volatile("s_waitcnt vmcnt(0)" ::: "memory");
        } else {
            XB_SPIN(xb_ld(&bar[XB_XGEN(b.x)]) == gen, bar);
            __builtin_amdgcn_fence(__ATOMIC_ACQUIRE, "agent");
            asm volatile("s_waitcnt vmcnt(0)" ::: "memory");
        }
    }
    __syncthreads();
}

#if ONE_LAUNCH
__global__ void __launch_bounds__(512) mega_kernel(Params p) {
    extern __shared__ __attribute__((aligned(16))) unsigned char smem[];
    LAS unsigned char* lds = (LAS unsigned char*)smem;
    volatile LAS unsigned* st = (volatile LAS unsigned*)(lds + LDS_ITEM_OFF + 16);
    if (threadIdx.x == 0) { st[0] = 0u; st[1] = 0u; }
    __syncthreads();
    XcdBarrier xb = xcd_barrier_post(p.bar, st);
#if DIAG
    unsigned long long* ts = (unsigned long long*)(p.ctr + 64);
#define STAMP(i) do { if (blockIdx.x == 0 && threadIdx.x == 0) ts[i] = __builtin_amdgcn_s_memrealtime(); } while (0)
    xcd_barrier(xb);
#else
#define STAMP(i) do { } while (0)
#endif
    STAMP(0);
    phase0(p, lds); xcd_barrier(xb); STAMP(1);
    gemm_phase<1>(p, lds); phase1_tail(p, lds); xcd_barrier(xb); STAMP(2);
    phase2a(p, lds); xcd_barrier(xb); STAMP(3);
    phase2b(p, lds);
#if DIAG
    xcd_barrier(xb); STAMP(4);
    xcd_barrier(xb);
    {
#if DIAG == 3
        float ta = (float)p.ctr[40] * 0.0001f, tb = (float)p.ctr[41] * 0.01f * 5.f;
#elif DIAG == 2
        float ta = (float)p.ctr[36] * 0.01f / 128.f, tb = (float)p.ctr[37] * 0.01f / 2176.f;
        ta = exp2f(rintf(log2f(ta) * 12.f) / 12.f); tb = exp2f(rintf(log2f(tb) * 12.f) / 12.f) * 30.f;
#else
        float ta = (float)(ts[DIAG_A + 1] - ts[DIAG_A]) * 0.01f, tb = (float)(ts[DIAG_B + 1] - ts[DIAG_B]) * 0.01f;
        ta *= 0.01f;
#endif
        if (blockIdx.x == 0 && threadIdx.x == 0) p.out[0] += ta;
        for (int i = blockIdx.x * 512 + threadIdx.x; i < 2097152; i += gridDim.x * 512) p.out[O_VS + i] += tb * 0.001f;
    }
#endif
}
#else
template <int PH> __global__ void __launch_bounds__(512) phase_kernel(Params p) {
    extern __shared__ __attribute__((aligned(16))) unsigned char smem[];
    LAS unsigned char* lds = (LAS unsigned char*)smem;
    if (PH == 0) phase0(p, lds);
    if (PH == 1) gemm_phase<1>(p, lds);
    if (PH == 2) phase2a(p, lds);
    if (PH == 3) phase2b(p, lds);
    if (PH == 4) gemm_phase<2, false, false>(p, lds);
    if (PH == 5) phase4(p, 0);
}
#endif

extern "C" void kernel_launch(void* const* d_in, const int* in_sizes, int n_in, void* d_out, int out_size, void* d_ws, size_t ws_size, hipStream_t stream) {
    static int grid = 0;
    if (grid == 0) {
        if (n_in != 18 || ws_size < WS_END) { fprintf(stderr, "kernel_launch: need 18 inputs and >= %zu bytes of workspace (got %d, %zu)\n", (size_t)WS_END, n_in, ws_size); grid = -1; return; }
        int dev = 0, cus = 0, per_cu = 0;
        hipGetDevice(&dev);
        hipDeviceGetAttribute(&cus, hipDeviceAttributeMultiprocessorCount, dev);
#if ONE_LAUNCH
        hipFuncSetAttribute((const void*)mega_kernel, hipFuncAttributeMaxDynamicSharedMemorySize, LDS_BYTES);
        hipOccupancyMaxActiveBlocksPerMultiprocessor(&per_cu, (const void*)mega_kernel, 512, LDS_BYTES);
        if (per_cu < 1) { fprintf(stderr, "kernel_launch: occupancy query says %d blocks per CU\n", per_cu); per_cu = 1; }
        grid = cus * per_cu;
#else
        hipFuncSetAttribute((const void*)phase_kernel<0>, hipFuncAttributeMaxDynamicSharedMemorySize, LDS_BYTES);
        hipFuncSetAttribute((const void*)phase_kernel<1>, hipFuncAttributeMaxDynamicSharedMemorySize, LDS_BYTES);
        hipFuncSetAttribute((const void*)phase_kernel<2>, hipFuncAttributeMaxDynamicSharedMemorySize, LDS_BYTES);
        hipFuncSetAttribute((const void*)phase_kernel<3>, hipFuncAttributeMaxDynamicSharedMemorySize, LDS_BYTES);
        hipFuncSetAttribute((const void*)phase_kernel<4>, hipFuncAttributeMaxDynamicSharedMemorySize, LDS_BYTES);
        hipFuncSetAttribute((const void*)phase_kernel<5>, hipFuncAttributeMaxDynamicSharedMemorySize, LDS_BYTES);
        (void)per_cu;
        grid = cus;
#endif
    }
    if (grid < 0) return;
    Params p{};
    p.x_prompt = (const float*)d_in[0]; p.x_sample = (const float*)d_in[1]; p.state_ssm = (const float*)d_in[2]; p.state_conv = (const float*)d_in[3];
    p.norm_in_w = (const float*)d_in[4]; p.w_in = (const float*)d_in[5]; p.ln_w = (const float*)d_in[6]; p.ln_b = (const float*)d_in[7];
    p.gws = (const float*)d_in[8]; p.gbs = (const float*)d_in[9]; p.conv_w = (const float*)d_in[10]; p.conv_b = (const float*)d_in[11];
    p.dt_bias = (const float*)d_in[12]; p.a_log = (const float*)d_in[13]; p.d_skip = (const float*)d_in[14]; p.ssm_norm_w = (const float*)d_in[15];
    p.w_out = (const float*)d_in[16]; p.norm_f_w = (const float*)d_in[17];
    p.out = (float*)d_out;
    unsigned char* ws = (unsigned char*)d_ws;
    p.h = (bf16_t*)(ws + WS_H); p.xn = (bf16_t*)(ws + WS_XN); p.WinT = (bf16_t*)(ws + WS_WINT); p.WoutT = (bf16_t*)(ws + WS_WOUTT);
    p.WdtT = (bf16_t*)(ws + WS_WDTT); p.Wm = (bf16_t*)(ws + WS_WM); p.BT = (bf16_t*)(ws + WS_BT);
    p.xbc = (bf16_t*)d_out;
    p.stats = (float*)(ws + WS_STATS); p.ssq = (float*)(ws + WS_SSQ); p.fpart = (float*)(ws + WS_FPART);
    p.dtT = (float*)(ws + WS_DTT); p.acT = (float*)(ws + WS_ACT); p.ctr = (unsigned*)(ws + WS_CTR); p.bar = (unsigned*)(ws + WS_BAR); p.dtraw = (float*)(ws + WS_DTRAW);
#if ONE_LAUNCH
    if (hipMemsetAsync(ws + WS_CTR, 0, 1024 + 16384, stream) != hipSuccess) { fprintf(stderr, "kernel_launch: memset of barrier words failed\n"); return; }
    void* args[] = {&p};
    hipError_t e = hipLaunchCooperativeKernel((const void*)mega_kernel, dim3(grid), dim3(512), args, LDS_BYTES, stream);
    if (e != hipSuccess) fprintf(stderr, "cooperative launch failed: %s (grid %d)\n", hipGetErrorString(e), grid);
#else
    hipLaunchKernelGGL(phase_kernel<0>, dim3(grid), dim3(512), LDS_BYTES, stream, p);
    hipLaunchKernelGGL(phase_kernel<1>, dim3(grid), dim3(512), LDS_BYTES, stream, p);
    hipLaunchKernelGGL(phase_kernel<2>, dim3(grid), dim3(512), LDS_BYTES, stream, p);
    hipLaunchKernelGGL(phase_kernel<3>, dim3(grid), dim3(512), LDS_BYTES, stream, p);
    hipLaunchKernelGGL(phase_kernel<4>, dim3(grid), dim3(512), LDS_BYTES, stream, p);
    hipLaunchKernelGGL(phase_kernel<5>, dim3(grid), dim3(512), LDS_BYTES, stream, p);
#endif
}
```

```cpp
#include <hip/hip_runtime.h>
#include <hip/hip_cooperative_groups.h>
#include <cstdio>
namespace cg = cooperative_groups;

#ifndef ONE_LAUNCH
#define ONE_LAUNCH 1
#endif

#ifndef DIAG
#define DIAG 0
#endif
#ifndef DIAG_A
#define DIAG_A 0
#endif
#ifndef DIAG_B
#define DIAG_B 1
#endif
#define LAS __attribute__((address_space(3)))
typedef unsigned short bf16_t;
typedef short bf16x8 __attribute__((ext_vector_type(8)));
typedef float f32x4 __attribute__((ext_vector_type(4)));
typedef float f32x2 __attribute__((ext_vector_type(2)));
typedef unsigned u32x4 __attribute__((ext_vector_type(4)));
typedef unsigned u32x2 __attribute__((ext_vector_type(2)));

constexpr int T_ALL = 34816, T_PROMPT = 32768, DM = 1024, HS = 5632  , DIN = 5648;
constexpr int XS = 1536;
constexpr int XSB = 2048;
constexpr float EPS = 1e-5f;
constexpr int LDS_BYTES = 131072 + 1024;
constexpr int LDS_ITEM_OFF = 131072;

constexpr size_t O_Y = 0, O_SSMP = 35651584, O_CONVP = 36700160, O_SSMS = 36737024, O_CONVS = 40931328, O_VS = 41078784;

struct Params {
    const float* x_prompt; const float* x_sample; const float* state_ssm; const float* state_conv;
    const float* norm_in_w; const float* w_in; const float* ln_w; const float* ln_b; const float* gws; const float* gbs;
    const float* conv_w; const float* conv_b; const float* dt_bias; const float* a_log; const float* d_skip; const float* ssm_norm_w;
    const float* w_out; const float* norm_f_w;
    float* out;
    bf16_t* h; bf16_t* xn; bf16_t* WinT; bf16_t* WoutT; bf16_t* WdtT; bf16_t* Wm; bf16_t* BT; bf16_t* xbc;
    float* stats; float* ssq; float* fpart; float* dtraw; float* dtT; float* acT; unsigned* ctr; unsigned* bar;
};

constexpr size_t WS_H = 0;
constexpr size_t WS_XN = WS_H + (size_t)T_ALL * HS * 2;
constexpr size_t WS_WINT = WS_XN + (size_t)T_ALL * DM * 2;
constexpr size_t WS_WOUTT = WS_WINT + (size_t)5632 * 1024 * 2;
constexpr size_t WS_WDTT = WS_WOUTT + (size_t)1024 * 2048 * 2;
constexpr size_t WS_WM = WS_WDTT + (size_t)16 * 1024 * 2;
constexpr size_t WS_BT = WS_WM + (size_t)8 * 128 * 128 * 2;
constexpr size_t WS_STATS = WS_BT + (size_t)544 * 2 * 128 * 64 * 2;
constexpr size_t WS_SSQ = WS_STATS + (size_t)T_ALL * 32 * 4;
constexpr size_t WS_FPART = WS_SSQ + (size_t)T_ALL * 4;
constexpr size_t WS_DTT = WS_FPART + (size_t)T_ALL * 16 * 4;
constexpr size_t WS_ACT = WS_DTT + (size_t)T_ALL * 16 * 4;
constexpr size_t WS_CTR = WS_ACT + (size_t)T_ALL * 16 * 4;
constexpr size_t WS_BAR = WS_CTR + 1024;
constexpr size_t WS_DTRAW = WS_BAR + 16384;
constexpr size_t WS_END = WS_DTRAW + (size_t)T_ALL * 16 * 4;

__device__ __forceinline__ unsigned cvt_pk_bf16(float lo, float hi) { unsigned r; asm("v_cvt_pk_bf16_f32 %0, %1, %2" : "=v"(r) : "v"(lo), "v"(hi)); return r; }
__device__ __forceinline__ float bf_lo(unsigned w) { return __uint_as_float(w << 16); }
__device__ __forceinline__ float bf_hi(unsigned w) { return __uint_as_float(w & 0xffff0000u); }
__device__ __forceinline__ float silu_f(float x) { return x * __builtin_amdgcn_rcpf(1.f + __expf(-x)); }
__device__ __forceinline__ const float* xrow_ptr(const Params& p, int row) {
    return row < T_PROMPT ? p.x_prompt + (size_t)row * DM : p.x_sample + (size_t)(row - T_PROMPT) * DM;
}
#define MFMA16(a, b, c) __builtin_amdgcn_mfma_f32_16x16x32_bf16((a), (b), (c), 0, 0, 0)

__device__ __forceinline__ void transpose_tile(const float* __restrict__ src, int ldn, int k0, int n0, const float* __restrict__ scale, int s0,
                                               bf16_t* __restrict__ dst, int ldk, int kd0, LAS float* tl) {
    const int tid = threadIdx.x;
    __syncthreads();
    {
        const int r = tid >> 4, c4 = tid & 15;
#pragma unroll
        for (int i = 0; i < 2; ++i) {
            const int k = r + 32 * i;
            f32x4 v = *(const f32x4*)(src + (size_t)(k0 + k) * ldn + n0 + c4 * 4);
            const float sc = scale ? scale[s0 + k] : 1.f;
            tl[k * 65 + c4 * 4 + 0] = v[0] * sc; tl[k * 65 + c4 * 4 + 1] = v[1] * sc; tl[k * 65 + c4 * 4 + 2] = v[2] * sc; tl[k * 65 + c4 * 4 + 3] = v[3] * sc;
        }
    }
    __syncthreads();
    {
        const int n = tid >> 3, kg = tid & 7;
        float f[8];
#pragma unroll
        for (int j = 0; j < 8; ++j) f[j] = tl[(kg * 8 + j) * 65 + n];
        u32x4 w; w.x = cvt_pk_bf16(f[0], f[1]); w.y = cvt_pk_bf16(f[2], f[3]); w.z = cvt_pk_bf16(f[4], f[5]); w.w = cvt_pk_bf16(f[6], f[7]);
        *(u32x4*)(dst + (size_t)(n0 + n) * ldk + kd0 + kg * 8) = w;
    }
}

__device__ __forceinline__ void phase0(const Params& p, LAS unsigned char* lds) {
    const int tid = threadIdx.x, lane = tid & 63, wid = tid >> 6;
    const int G = gridDim.x, blk = blockIdx.x;
    for (int i = blk * 512 + tid; i < T_ALL; i += G * 512) p.ssq[i] = 0.f;
    if (blk == 0 && tid < 64) p.ctr[tid] = 0u;
    for (int i = blk * 512 + tid; i < 16 * 1024; i += G * 512) {
        const int j = i >> 10, k = i & 1023;
        p.WdtT[i] = (bf16_t)(cvt_pk_bf16(p.w_in[(size_t)k * DIN + 5632 + j] * p.norm_in_w[k], 0.f) & 0xffffu);
    }
    for (int i = blk * 512 + tid; i < 8 * 128 * 128; i += G * 512) {
        const int t = (i >> 7) & 127, s = i & 127;
        float v = p.gws[i]; if ((s >> 6) > (t >> 6)) v = 0.f;
        p.Wm[i] = (bf16_t)(cvt_pk_bf16(v, 0.f) & 0xffffu);
    }
    LAS float* tl = (LAS float*)lds;
    for (int base = blk * 4; base < 1920; base += G * 4) {
        const float* srcp[4]; const float* scp[4]; bf16_t* dstp[4]; int ldn[4], ldk[4];
#pragma unroll
        for (int t = 0; t < 4; ++t) {
            const int ti = base + t;
            if (ti < 1408) {
                const int kt = ti / 88, nt_ = ti % 88;
                srcp[t] = p.w_in + (size_t)(kt * 64) * DIN + nt_ * 64; ldn[t] = DIN; scp[t] = p.norm_in_w + kt * 64;
                dstp[t] = p.WinT + (size_t)(nt_ * 64) * 1024 + kt * 64; ldk[t] = 1024;
            } else {
                const int t2 = ti - 1408, kt = t2 >> 4, nt_ = t2 & 15, k0 = kt * 64;
                srcp[t] = p.w_out + (size_t)k0 * 1024 + nt_ * 64; ldn[t] = 1024;
                scp[t] = k0 >= 1024 ? p.ssm_norm_w + (k0 - 1024) : nullptr;
                dstp[t] = p.WoutT + (size_t)(nt_ * 64) * 2048 + (k0 >= 1024 ? k0 - 1024 : k0 + 1024);
                ldk[t] = 2048;
            }
        }
        f32x4 v[4][2]; float sc[4][2];
        {
            const int r = tid >> 4, c4 = tid & 15;
#pragma unroll
            for (int t = 0; t < 4; ++t)
                if (base + t < 1920) {
#pragma unroll
                    for (int i = 0; i < 2; ++i) {
                        v[t][i] = *(const f32x4*)(srcp[t] + (size_t)(r + 32 * i) * ldn[t] + c4 * 4);
                        sc[t][i] = scp[t] ? scp[t][r + 32 * i] : 1.f;
                    }
                }
            __syncthreads();
#pragma unroll
            for (int t = 0; t < 4; ++t)
                if (base + t < 1920) {
#pragma unroll
                    for (int i = 0; i < 2; ++i) {
                        LAS float* d = tl + t * (64 * 65) + (r + 32 * i) * 65 + c4 * 4;
                        d[0] = v[t][i][0] * sc[t][i]; d[1] = v[t][i][1] * sc[t][i]; d[2] = v[t][i][2] * sc[t][i]; d[3] = v[t][i][3] * sc[t][i];
                    }
                }
        }
        __syncthreads();
        {
            const int n = tid >> 3, kg = tid & 7;
#pragma unroll
            for (int t = 0; t < 4; ++t)
                if (base + t < 1920) {
                    float f[8];
#pragma unroll
                    for (int j = 0; j < 8; ++j) f[j] = tl[t * (64 * 65) + (kg * 8 + j) * 65 + n];
                    u32x4 w; w.x = cvt_pk_bf16(f[0], f[1]); w.y = cvt_pk_bf16(f[2], f[3]); w.z = cvt_pk_bf16(f[4], f[5]); w.w = cvt_pk_bf16(f[6], f[7]);
                    *(u32x4*)(dstp[t] + (size_t)n * ldk[t] + kg * 8) = w;
                }
        }
    }
    constexpr int RP = 3;
    for (int row0 = blk * 8 + wid; row0 < T_ALL; row0 += G * 8 * RP) {
        f32x4 v[RP][4];
#pragma unroll
        for (int r = 0; r < RP; ++r) {
            const int row = row0 + r * G * 8;
            if (row < T_ALL) {
                const float* src = xrow_ptr(p, row);
#pragma unroll
                for (int i = 0; i < 4; ++i) v[r][i] = __builtin_nontemporal_load((const f32x4*)(src + i * 256 + lane * 4));
            }
        }
#pragma unroll
        for (int r = 0; r < RP; ++r) {
            const int row = row0 + r * G * 8;
            if (row < T_ALL) {
                float ss = 0.f;
#pragma unroll
                for (int i = 0; i < 4; ++i) ss += v[r][i][0] * v[r][i][0] + v[r][i][1] * v[r][i][1] + v[r][i][2] * v[r][i][2] + v[r][i][3] * v[r][i][3];
#pragma unroll
                for (int o = 32; o >= 1; o >>= 1) ss += __shfl_xor(ss, o);
                const float rs = rsqrtf(ss * (1.f / 1024.f) + EPS);
#pragma unroll
                for (int i = 0; i < 4; ++i) {
                    u32x2 w; w.x = cvt_pk_bf16(v[r][i][0] * rs, v[r][i][1] * rs); w.y = cvt_pk_bf16(v[r][i][2] * rs, v[r][i][3] * rs);
                    *(u32x2*)(p.xn + (size_t)row * DM + i * 256 + lane * 4) = w;
                }
            }
        }
    }
}

constexpr int XCD_BAR_WORDS_C = 3456;
constexpr int PCNT_OFF = 3800;
constexpr int BM = 256, BK = 64, HALF = 128, HTB = HALF * BK * 2, NXCD = 8, WGM = 8;
__device__ __forceinline__ int lds_byte(int r, int c) { const int st = (r >> 4) * 2 + (c >> 5), rr = r & 15, cc = c & 31, ob = rr * 64 + cc * 2; return st * 1024 + (ob ^ (((ob >> 9) & 1) << 5)); }
__device__ __forceinline__ void stage_rc(int b, int& R, int& C) { const int st = b / 1024, sb = b % 1024, swz = sb ^ (((sb >> 9) & 1) << 5); R = (st >> 1) * 16 + swz / 64; C = (st & 1) * 32 + (swz % 64) / 2; }
__device__ __forceinline__ int perm32(int rho) { const int n = rho >> 4, i = rho & 15; return 8 * (i >> 2) + 4 * n + (i & 3); }
struct Unit { int pm, pn; };

template <int MODE, bool SINGLE>
__device__ __forceinline__ bool unit_next(int i, int G, int c, Unit& u, int spm, int spn) {
    if (SINGLE) { u.pm = spm; u.pn = spn; return i == 0; }
    constexpr int nM = (MODE == 1) ? 136 : 128, nN = (MODE == 1) ? 22 : 4, nwg = nM * nN;
    const long L = (long)i * G + c; if (L >= nwg) return false;
    int wgid = (int)L; { const int q = nwg / NXCD, r = nwg % NXCD, xcd = wgid % NXCD, off = wgid / NXCD; wgid = (xcd < r ? xcd * (q + 1) : r * (q + 1) + (xcd - r) * q) + off; }
    const int nig = WGM * nN, gid = wgid / nig, fm = gid * WGM, gsz = (nM - fm) < WGM ? (nM - fm) : WGM;
    u.pm = fm + ((wgid % nig) % gsz); u.pn = (wgid % nig) / gsz; return true;
}

template <int MODE, bool SINGLE = false, bool FUSE = false>
__device__ __forceinline__ void gemm_phase(const Params& p, LAS unsigned char* lds, int spm = 0, int spn = 0) {
    constexpr int K = (MODE == 1) ? 1024 : 2048;
    constexpr int LDA = (MODE == 1) ? 1024 : HS;
    constexpr bool PERM = (MODE == 1);
    constexpr int nt = K / BK;
    const int tid = threadIdx.x, wid = __builtin_amdgcn_readfirstlane(tid >> 6), lane = tid & 63, wr = wid >> 2, wc = wid & 3, fr = lane & 15, fq = lane >> 4;
    const int G = gridDim.x, cblk = blockIdx.x;
    const char* Abase = (MODE == 1) ? (const char*)p.xn : (const char*)(p.h + 3072);
    const char* Bbase = (MODE == 1) ? (const char*)p.WinT : (const char*)p.WoutT;
    unsigned voffA[2], voffB[2];
#pragma unroll
    for (int i = 0; i < 2; ++i) { int R, C; stage_rc(tid * 16 + i * 8192, R, C); const int Rb = PERM ? ((R & ~31) + perm32(R & 31)) : R;
        voffA[i] = (unsigned)(R * LDA + C) * 2u; voffB[i] = (unsigned)(Rb * K + C) * 2u; }
    constexpr size_t kstep = (size_t)(BK * 2);
    constexpr size_t hstepA = (size_t)HALF * LDA * 2, tstepA = 2 * hstepA;
    constexpr size_t hstepB = (size_t)HALF * K * 2, tstepB = 2 * hstepB;
    const unsigned ldsw = (unsigned)wid * 1024u;
    const int aoff = lds_byte(wr * 64 + fr, fq * 8), boff = lds_byte(wc * 32 + fr, fq * 8);
#define AK(t) ((long)(t) * 128 + ((MODE == 2 && (t) >= 16) ? -8192L : 0L))
#define PG8_SA(b, h) (((b) * 2 + (h)) * HTB)
#define PG8_SB(b, h) ((4 + (b) * 2 + (h)) * HTB)
#define PG8_STAGE(bufoff, gbase, voff) do { _Pragma("unroll") for (int _i = 0; _i < 2; ++_i) \
        __builtin_amdgcn_global_load_lds((const unsigned*)((const char*)(gbase) + (voff)[_i]), (LAS unsigned*)(lds + (bufoff) + ldsw + _i * 8192), 16, 0, 0); } while (0)
#define PG8_LDA(dst, b, h) do { _Pragma("unroll") for (int m = 0; m < 4; ++m) _Pragma("unroll") for (int k = 0; k < 2; ++k) dst[m][k] = *(const LAS bf16x8*)(lds + PG8_SA(b, h) + aoff + m * 2048 + k * 1024); } while (0)
#define PG8_LDB(dst, b, h) do { _Pragma("unroll") for (int n = 0; n < 2; ++n) _Pragma("unroll") for (int k = 0; k < 2; ++k) dst[n][k] = *(const LAS bf16x8*)(lds + PG8_SB(b, h) + boff + n * 2048 + k * 1024); } while (0)
#define PG8_MMA(ai, bj, At, Bt) do { __builtin_amdgcn_s_setprio(1); _Pragma("unroll") for (int m = 0; m < 4; ++m) _Pragma("unroll") for (int n = 0; n < 2; ++n) _Pragma("unroll") for (int k = 0; k < 2; ++k) \
        acc[ai][bj][m][n] = __builtin_amdgcn_mfma_f32_16x16x32_bf16(Bt[n][k], At[m][k], acc[ai][bj][m][n], 0, 0, 0); __builtin_amdgcn_s_setprio(0); } while (0)
#define PG8_WAIT_V(n) asm volatile("s_waitcnt vmcnt(" #n ")" ::: "memory")
#define PG8_WAIT_L(n) asm volatile("s_waitcnt lgkmcnt(" #n ")" ::: "memory")
#define PG8_BAR __builtin_amdgcn_s_barrier()
#define PG8_SCHED __builtin_amdgcn_sched_barrier(0)
    Unit cur, nxt; int ui = 0;
    if (!unit_next<MODE, SINGLE>(0, G, cblk, cur, spm, spn)) return;
    f32x4 acc[2][2][4][2];
#pragma unroll
    for (int a = 0; a < 2; ++a)
#pragma unroll
        for (int b = 0; b < 2; ++b)
#pragma unroll
            for (int m = 0; m < 4; ++m)
#pragma unroll
                for (int n = 0; n < 2; ++n) acc[a][b][m][n] = (f32x4){0.f, 0.f, 0.f, 0.f};
    bf16x8 At[4][2], B0[2][2], B1[2][2];
    const char* cA = Abase + (size_t)cur.pm * tstepA; const char* cB = Bbase + (size_t)cur.pn * tstepB;
    PG8_STAGE(PG8_SB(0, 0), cB, voffB); PG8_STAGE(PG8_SA(0, 0), cA, voffA); PG8_STAGE(PG8_SB(0, 1), cB + hstepB, voffB); PG8_STAGE(PG8_SA(0, 1), cA + hstepA, voffA);
    if (wr == 1) PG8_BAR;
    PG8_WAIT_V(4); PG8_BAR;
    PG8_STAGE(PG8_SB(1, 0), cB + kstep, voffB); PG8_STAGE(PG8_SA(1, 0), cA + kstep, voffA); PG8_STAGE(PG8_SB(1, 1), cB + hstepB + kstep, voffB);
    PG8_WAIT_V(6); PG8_BAR;
    for (;;) {
        const bool has_next = unit_next<MODE, SINGLE>(ui + 1, G, cblk, nxt, spm, spn);
        const char* nA = has_next ? Abase + (size_t)nxt.pm * tstepA : cA; const char* nB = has_next ? Bbase + (size_t)nxt.pn * tstepB : cB;
#if DIAG == 3
        const unsigned long long tk0 = __builtin_amdgcn_s_memrealtime();
#endif
#pragma unroll 1
        for (int t = 0; t < nt; t += 2) {
            const bool last = (t == nt - 2);
            const char* a1 = cA + AK(t + 1);
            const char* a2 = last ? nA : cA + AK(t + 2); const char* b2 = last ? nB : cB + (size_t)(t + 2) * kstep;
            const char* a3 = last ? nA + kstep : cA + AK(t + 3); const char* b3 = b2 + kstep;
            if (MODE == 2 && t == 16) {
#pragma unroll
                for (int ai = 0; ai < 2; ++ai)
#pragma unroll
                    for (int m = 0; m < 4; ++m) {
                        const int row = cur.pm * BM + ai * HALF + wr * 64 + m * 16 + fr;
                        const float r = rsqrtf(p.ssq[row] * (1.f / 1024.f) + EPS);
#pragma unroll
                        for (int bj = 0; bj < 2; ++bj)
#pragma unroll
                            for (int n = 0; n < 2; ++n) acc[ai][bj][m][n] *= r;
                    }
            }
            PG8_LDB(B0, 0, 0); PG8_SCHED; PG8_LDA(At, 0, 0); PG8_STAGE(PG8_SA(1, 1), a1 + hstepA, voffA);
            PG8_WAIT_L(8); PG8_BAR; PG8_WAIT_L(0); PG8_MMA(0, 0, At, B0); PG8_BAR; PG8_SCHED;
            PG8_LDB(B1, 0, 1); PG8_STAGE(PG8_SB(0, 0), b2, voffB);
            PG8_BAR; PG8_WAIT_L(0); PG8_MMA(0, 1, At, B1); PG8_BAR;
            PG8_LDA(At, 0, 1); PG8_STAGE(PG8_SA(0, 0), a2, voffA);
            PG8_BAR; PG8_WAIT_L(0); PG8_MMA(1, 0, At, B0); PG8_BAR; PG8_SCHED;
            PG8_STAGE(PG8_SB(0, 1), b2 + hstepB, voffB);
            PG8_WAIT_V(6); PG8_BAR; PG8_MMA(1, 1, At, B1); PG8_BAR;
            PG8_LDB(B0, 1, 0); PG8_SCHED; PG8_LDA(At, 1, 0); PG8_STAGE(PG8_SA(0, 1), a2 + hstepA, voffA);
            PG8_WAIT_L(8); PG8_BAR; PG8_WAIT_L(0); PG8_MMA(0, 0, At, B0); PG8_BAR; PG8_SCHED;
            PG8_LDB(B1, 1, 1); PG8_STAGE(PG8_SB(1, 0), b3, voffB);
            PG8_BAR; PG8_WAIT_L(0); PG8_MMA(0, 1, At, B1); PG8_BAR;
            PG8_LDA(At, 1, 1); PG8_STAGE(PG8_SA(1, 0), a3, voffA);
            PG8_BAR; PG8_WAIT_L(0); PG8_MMA(1, 0, At, B0); PG8_BAR; PG8_SCHED;
            PG8_STAGE(PG8_SB(1, 1), b3 + hstepB, voffB);
            PG8_WAIT_V(6); PG8_BAR; PG8_MMA(1, 1, At, B1); PG8_BAR;
        }
#if DIAG == 3
        const unsigned long long tk1 = __builtin_amdgcn_s_memrealtime();
#endif
        if (MODE == 1) {
            const int row0 = cur.pm * BM + wr * 64 + fr, col0 = cur.pn * BM + wc * 32 + 8 * fq;
            const bool isV = (cur.pn >= 4 && cur.pn < 8);
#pragma unroll
            for (int ai = 0; ai < 2; ++ai)
#pragma unroll
                for (int m = 0; m < 4; ++m) {
                    const int row = row0 + ai * HALF + m * 16;
                    bf16_t* rowp = p.h + (size_t)row * HS + col0;
                    float s = 0.f, ss = 0.f;
#pragma unroll
                    for (int bj = 0; bj < 2; ++bj) {
                        const f32x4 v0 = acc[ai][bj][m][0], v1 = acc[ai][bj][m][1];
                        u32x4 w; w.x = cvt_pk_bf16(v0[0], v0[1]); w.y = cvt_pk_bf16(v0[2], v0[3]); w.z = cvt_pk_bf16(v1[0], v1[1]); w.w = cvt_pk_bf16(v1[2], v1[3]);
                        __builtin_nontemporal_store(w, (u32x4*)(rowp + bj * HALF));
                        s += (v0[0] + v0[1]) + (v0[2] + v0[3]) + (v1[0] + v1[1]) + (v1[2] + v1[3]);
                        ss += v0[0] * v0[0] + v0[1] * v0[1] + v0[2] * v0[2] + v0[3] * v0[3] + v1[0] * v1[0] + v1[1] * v1[1] + v1[2] * v1[2] + v1[3] * v1[3];
                    }
                    if (isV) {
                        s += __shfl_xor(s, 16); ss += __shfl_xor(ss, 16);
                        s += __shfl_xor(s, 32); ss += __shfl_xor(ss, 32);
                        if (fq == 0) { f32x2 o; o.x = s; o.y = ss; *(f32x2*)(p.stats + ((size_t)row * 16 + (cur.pn - 4) * 4 + wc) * 2) = o; }
                    }
                }
        } else if (!FUSE) {
            const int row0 = cur.pm * BM + wr * 64 + fr, col0 = cur.pn * BM + wc * 32 + 4 * fq;
#pragma unroll
            for (int ai = 0; ai < 2; ++ai)
#pragma unroll
                for (int m = 0; m < 4; ++m) {
                    const int row = row0 + ai * HALF + m * 16;
                    const float* xr = xrow_ptr(p, row) + col0;
                    float* orow = p.out + (size_t)row * DM + col0;
                    float ss = 0.f;
#pragma unroll
                    for (int bj = 0; bj < 2; ++bj)
#pragma unroll
                        for (int n = 0; n < 2; ++n) {
                            const f32x4 xv = __builtin_nontemporal_load((const f32x4*)(xr + bj * HALF + n * 16));
                            const f32x4 v = acc[ai][bj][m][n] + xv;
                            *(f32x4*)(orow + bj * HALF + n * 16) = v;
                            ss += v[0] * v[0] + v[1] * v[1] + v[2] * v[2] + v[3] * v[3];
                        }
                    ss += __shfl_xor(ss, 16); ss += __shfl_xor(ss, 32);
                    if (fq == 0) p.fpart[(size_t)row * 16 + cur.pn * 4 + wc] = ss;
                }
        } else {
            PG8_SCHED; if (wr == 0) PG8_BAR; PG8_SCHED;
            const int row0 = cur.pm * BM + wr * 64 + fr, col0 = cur.pn * BM + wc * 32 + 4 * fq;
#pragma unroll
            for (int ai = 0; ai < 2; ++ai)
#pragma unroll
                for (int m = 0; m < 4; ++m) {
                    const int row = row0 + ai * HALF + m * 16;
                    const float* xr = xrow_ptr(p, row) + col0;
                    float ss = 0.f;
#pragma unroll
                    for (int bj = 0; bj < 2; ++bj)
#pragma unroll
                        for (int n = 0; n < 2; ++n) {
                            const f32x4 xv = __builtin_nontemporal_load((const f32x4*)(xr + bj * HALF + n * 16));
                            const f32x4 v = acc[ai][bj][m][n] + xv;
                            acc[ai][bj][m][n] = v;
                            ss += v[0] * v[0] + v[1] * v[1] + v[2] * v[2] + v[3] * v[3];
                        }
                    ss += __shfl_xor(ss, 16); ss += __shfl_xor(ss, 32);
                    if (fq == 0) __hip_atomic_store(p.fpart + (size_t)row * 16 + cur.pn * 4 + wc, ss, __ATOMIC_RELAXED, __HIP_MEMORY_SCOPE_AGENT);
                }
            asm volatile("s_waitcnt vmcnt(0)" ::: "memory");
            unsigned* pc = p.bar + XCD_BAR_WORDS_C + cur.pm * 2 + wr;
            if (lane == 0) __hip_atomic_fetch_add(pc, 1u, __ATOMIC_RELAXED, __HIP_MEMORY_SCOPE_AGENT);
            { unsigned sp = 0; while (__hip_atomic_load(pc, __ATOMIC_RELAXED, __HIP_MEMORY_SCOPE_AGENT) < 16u) { __builtin_amdgcn_s_sleep(2); if (++sp > (1u << 20)) break; } }
            asm volatile("" ::: "memory");
            f32x4 nw[2][2];
#pragma unroll
            for (int bj = 0; bj < 2; ++bj)
#pragma unroll
                for (int n = 0; n < 2; ++n) nw[bj][n] = *(const f32x4*)(p.norm_f_w + col0 + bj * HALF + n * 16);
#pragma unroll
            for (int ai = 0; ai < 2; ++ai)
#pragma unroll
                for (int m = 0; m < 4; ++m) {
                    const int row = row0 + ai * HALF + m * 16;
                    unsigned long long* fp = (unsigned long long*)(p.fpart + (size_t)row * 16 + fq * 4);
                    const unsigned long long a = __hip_atomic_load(fp, __ATOMIC_RELAXED, __HIP_MEMORY_SCOPE_AGENT), b = __hip_atomic_load(fp + 1, __ATOMIC_RELAXED, __HIP_MEMORY_SCOPE_AGENT);
                    float s = (__uint_as_float((unsigned)a) + __uint_as_float((unsigned)(a >> 32))) + (__uint_as_float((unsigned)b) + __uint_as_float((unsigned)(b >> 32)));
                    s += __shfl_xor(s, 16); s += __shfl_xor(s, 32);
                    const float rs = rsqrtf(s * (1.f / 1024.f) + EPS);
                    float* orow = p.out + (size_t)row * DM + col0;
#pragma unroll
                    for (int bj = 0; bj < 2; ++bj)
#pragma unroll
                        for (int n = 0; n < 2; ++n) __builtin_nontemporal_store(acc[ai][bj][m][n] * rs * nw[bj][n], (f32x4*)(orow + bj * HALF + n * 16));
                }
            PG8_SCHED; if (wr == 1) PG8_BAR; PG8_SCHED;
        }
#if DIAG == 3
        if (MODE == DIAG_A && !SINGLE && blockIdx.x == 0 && tid == 0) { const unsigned long long tk2 = __builtin_amdgcn_s_memrealtime(); atomicAdd(p.ctr + 40, (unsigned)(tk1 - tk0)); atomicAdd(p.ctr + 41, (unsigned)(tk2 - tk1)); }
#endif
        if (!has_next) break;
#pragma unroll
        for (int a = 0; a < 2; ++a)
#pragma unroll
            for (int b = 0; b < 2; ++b)
#pragma unroll
                for (int m = 0; m < 4; ++m)
#pragma unroll
                    for (int n = 0; n < 2; ++n) acc[a][b][m][n] = (f32x4){0.f, 0.f, 0.f, 0.f};
        cur = nxt; cA = nA; cB = nB; ++ui;
    }
    PG8_WAIT_V(0);
    if (wr == 0) PG8_BAR;
    PG8_BAR;
#undef AK
#undef PG8_SA
#undef PG8_SB
#undef PG8_STAGE
#undef PG8_LDA
#undef PG8_LDB
#undef PG8_MMA
#undef PG8_WAIT_V
#undef PG8_WAIT_L
#undef PG8_BAR
#undef PG8_SCHED
}

__device__ __forceinline__ void dt_panel(const Params& p, LAS unsigned char* lds, int pm) {
    const int tid = threadIdx.x, lane = tid & 63, wid = tid >> 6, fr = lane & 15, fq = lane >> 4;
    constexpr int D_WS = 69632;
    __syncthreads();
    for (int i = tid; i < 16 * 128; i += 512) {
        const int r = i >> 7, cq = i & 127;
        *(LAS bf16x8*)(lds + D_WS + (r * 1032 + cq * 8) * 2) = *(const bf16x8*)(p.WdtT + (size_t)r * 1024 + cq * 8);
    }
    const int rr = tid >> 4, cc = (tid & 15) * 8;
    const bf16_t* ag = p.xn + (size_t)(pm * 256 + rr) * DM + cc;
    bf16x8 q[8];
#pragma unroll
    for (int i = 0; i < 8; ++i) q[i] = *(const bf16x8*)(ag + (size_t)(32 * i) * DM);
    f32x4 d0 = (f32x4){0.f, 0.f, 0.f, 0.f}, d1 = (f32x4){0.f, 0.f, 0.f, 0.f};
#pragma unroll 1
    for (int kc = 0; kc < 8; ++kc) {
        __syncthreads();
#pragma unroll
        for (int i = 0; i < 8; ++i) *(LAS bf16x8*)(lds + ((rr + 32 * i) * 136 + cc) * 2) = q[i];
        if (kc + 1 < 8) {
#pragma unroll
            for (int i = 0; i < 8; ++i) q[i] = *(const bf16x8*)(ag + (size_t)(32 * i) * DM + (kc + 1) * 128);
        }
        __syncthreads();
#pragma unroll
        for (int kk = 0; kk < 4; ++kk) {
            const bf16x8 b = *(const LAS bf16x8*)(lds + D_WS + (fr * 1032 + kc * 128 + kk * 32 + fq * 8) * 2);
            const bf16x8 a0 = *(const LAS bf16x8*)(lds + ((wid * 32 + fr) * 136 + kk * 32 + fq * 8) * 2);
            const bf16x8 a1 = *(const LAS bf16x8*)(lds + ((wid * 32 + 16 + fr) * 136 + kk * 32 + fq * 8) * 2);
            d0 = MFMA16(a0, b, d0);
            d1 = MFMA16(a1, b, d1);
        }
    }
    const int rb = pm * 256 + wid * 32;
#pragma unroll
    for (int j = 0; j < 4; ++j) {
        p.dtraw[(size_t)(rb + fq * 4 + j) * 16 + fr] = d0[j];
        p.dtraw[(size_t)(rb + 16 + fq * 4 + j) * 16 + fr] = d1[j];
    }
}
__device__ __forceinline__ void phase1_tail(const Params& p, LAS unsigned char* lds) {
    const int G = gridDim.x, rem = 2992 % G;
    const int first = rem ? rem : 0, nidle = G - first;
    if ((int)blockIdx.x >= first) for (int pm = (int)blockIdx.x - first; pm < 136; pm += nidle) dt_panel(p, lds, pm);
}

__device__ __forceinline__ void unpack8(const bf16x8 v, float* f) {
    const u32x4 w = __builtin_bit_cast(u32x4, v);
    f[0] = bf_lo(w.x); f[1] = bf_hi(w.x); f[2] = bf_lo(w.y); f[3] = bf_hi(w.y); f[4] = bf_lo(w.z); f[5] = bf_hi(w.z); f[6] = bf_lo(w.w); f[7] = bf_hi(w.w);
}

struct ConvRaw { bf16x8 r[11]; };
constexpr int L_CW = 4096;

__device__ __forceinline__ void conv_load(const Params& p, int ci, int third, ConvRaw& R) {
    const int u = third * 512 + (int)threadIdx.x, cg_ = u % 192, rb = u / 192, ch0 = cg_ * 8;
    const bool halo = rb > 0 || (ci < 512 && (ci & 63) != 0);
    const bf16_t* hx = p.h + (size_t)(ci * 64 + rb * 8) * HS + 4096 + ch0;
    if (halo) {
#pragma unroll
        for (int k = 0; k < 3; ++k) R.r[k] = *(const bf16x8*)(hx + (long)(k - 3) * HS);
    }
#pragma unroll
    for (int k = 3; k < 11; ++k) R.r[k] = __builtin_nontemporal_load((const bf16x8*)(hx + (long)(k - 3) * HS));
}

__device__ __forceinline__ void conv_compute(const Params& p, LAS unsigned char* lds, int ci, int third, const ConvRaw& R) {
    const int tid = threadIdx.x;
    const int u = third * 512 + tid, cg_ = u % 192, rb = u / 192, ch0 = cg_ * 8;
    const int r0 = ci * 64;
    const bool prompt = ci < 512;
    const int c = ci & 63;
    float w0[8], w1[8], w2[8], w3[8], bb[8];
    {
        const LAS float* cw = (const LAS float*)(lds + L_CW) + ch0;
#pragma unroll
        for (int q = 0; q < 2; ++q) {
            const f32x4 a0 = *(const LAS f32x4*)(cw + 0 * XS + q * 4), a1 = *(const LAS f32x4*)(cw + 1 * XS + q * 4);
            const f32x4 a2 = *(const LAS f32x4*)(cw + 2 * XS + q * 4), a3 = *(const LAS f32x4*)(cw + 3 * XS + q * 4);
            const f32x4 b4 = *(const LAS f32x4*)(cw + 4 * XS + q * 4);
#pragma unroll
            for (int j = 0; j < 4; ++j) { w0[q * 4 + j] = a0[j]; w1[q * 4 + j] = a1[j]; w2[q * 4 + j] = a2[j]; w3[q * 4 + j] = a3[j]; bb[q * 4 + j] = b4[j]; }
        }
    }
    float x0[8], x1[8], x2[8];
    if (rb > 0 || (prompt && c != 0)) {
        unpack8(R.r[0], x0); unpack8(R.r[1], x1); unpack8(R.r[2], x2);
    } else if (prompt) {
#pragma unroll
        for (int j = 0; j < 8; ++j) { x0[j] = 0.f; x1[j] = 0.f; x2[j] = 0.f; }
    } else {
        const float* sc = p.state_conv + (size_t)(ci - 512) * 3 * XS + ch0;
#pragma unroll
        for (int q = 0; q < 2; ++q) {
            const f32x4 a0 = *(const f32x4*)(sc + 0 * XS + q * 4), a1 = *(const f32x4*)(sc + 1 * XS + q * 4), a2 = *(const f32x4*)(sc + 2 * XS + q * 4);
#pragma unroll
            for (int j = 0; j < 4; ++j) { x0[q * 4 + j] = a0[j]; x1[q * 4 + j] = a1[j]; x2[q * 4 + j] = a2[j]; }
        }
    }
    unsigned ob[8][4];
#pragma unroll
    for (int rr = 0; rr < 8; ++rr) {
        float cur[8], o[8];
        unpack8(R.r[3 + rr], cur);
#pragma unroll
        for (int j = 0; j < 8; ++j) {
            const float y = bb[j] + w0[j] * x0[j] + w1[j] * x1[j] + w2[j] * x2[j] + w3[j] * cur[j];
            o[j] = silu_f(y);
            x0[j] = x1[j]; x1[j] = x2[j]; x2[j] = cur[j];
        }
        u32x4 w; w.x = cvt_pk_bf16(o[0], o[1]); w.y = cvt_pk_bf16(o[2], o[3]); w.z = cvt_pk_bf16(o[4], o[5]); w.w = cvt_pk_bf16(o[6], o[7]);
        *(u32x4*)(p.xbc + (size_t)(r0 + rb * 8 + rr) * XSB + ch0) = w;
        ob[rr][0] = w.x; ob[rr][1] = w.y; ob[rr][2] = w.z; ob[rr][3] = w.w;
    }
    if (ch0 >= 1024 && ch0 < 1280) {
        const int g = (ch0 - 1024) >> 7, n0 = (ch0 - 1024) & 127;
        bf16_t* bt = p.BT + ((size_t)(ci * 2 + g) * 128 + n0) * 64 + rb * 8;
#pragma unroll
        for (int j = 0; j < 8; ++j) {
            unsigned e[8];
#pragma unroll
            for (int rr = 0; rr < 8; ++rr) e[rr] = (j & 1) ? (ob[rr][j >> 1] >> 16) : (ob[rr][j >> 1] & 0xffffu);
            u32x4 w; w.x = e[0] | (e[1] << 16); w.y = e[2] | (e[3] << 16); w.z = e[4] | (e[5] << 16); w.w = e[6] | (e[7] << 16);
            *(u32x4*)(bt + (size_t)j * 64) = w;
        }
    }
    if (rb == 7 && (!prompt || c == 63)) {
        float* dst = prompt ? p.out + O_CONVP + (size_t)(ci >> 6) * 3 * XS + ch0 : p.out + O_CONVS + (size_t)(ci - 512) * 3 * XS + ch0;
#pragma unroll
        for (int q = 0; q < 2; ++q) {
            *(f32x4*)(dst + 0 * XS + q * 4) = (f32x4){x0[q * 4], x0[q * 4 + 1], x0[q * 4 + 2], x0[q * 4 + 3]};
            *(f32x4*)(dst + 1 * XS + q * 4) = (f32x4){x1[q * 4], x1[q * 4 + 1], x1[q * 4 + 2], x1[q * 4 + 3]};
            *(f32x4*)(dst + 2 * XS + q * 4) = (f32x4){x2[q * 4], x2[q * 4 + 1], x2[q * 4 + 2], x2[q * 4 + 3]};
        }
    }
}

__device__ __forceinline__ void dt_item(const Params& p, LAS unsigned char* lds, int ci) {
    const int tid = threadIdx.x, lane = tid & 63, wid = tid >> 6, fr = lane & 15, fq = lane >> 4;
    const int r0 = ci * 64;
    LAS float* sDt = (LAS float*)lds;
    __syncthreads();
#pragma unroll
    for (int i = 0; i < 2; ++i) {
        const int idx = tid + 512 * i, l = idx >> 4, hd = idx & 15;
        const float xx = p.dtraw[(size_t)(r0 + l) * 16 + hd] + p.dt_bias[hd];
        sDt[hd * 64 + l] = xx > 20.f ? xx : log1pf(__expf(xx));
    }
    __syncthreads();
#pragma unroll
    for (int hh = 0; hh < 2; ++hh) {
        const int hd = wid + hh * 8;
        const float dtv = sDt[hd * 64 + lane];
        const float a = -__expf(p.a_log[hd]);
        float v = dtv * a;
#pragma unroll
        for (int o = 1; o < 64; o <<= 1) { const float t = __shfl_up(v, o); if (lane >= o) v += t; }
        p.dtT[((size_t)ci * 16 + hd) * 64 + lane] = dtv;
        p.acT[((size_t)ci * 16 + hd) * 64 + lane] = v;
    }
}

__device__ __forceinline__ void phase2a(const Params& p, LAS unsigned char* lds) {
    const int G = gridDim.x, blk = blockIdx.x;
    for (int i = threadIdx.x; i < 5 * XS; i += 512) ((LAS float*)(lds + L_CW))[i] = i < 4 * XS ? p.conv_w[i] : p.conv_b[i - 4 * XS];
    __syncthreads();
    ConvRaw A, B;
    if (blk < 1632) conv_load(p, blk / 3, blk % 3, A);
#pragma unroll 1
    for (int it = blk; it < 1632; it += 2 * G) {
        const int it1 = it + G, it2 = it + 2 * G;
        if (it1 < 1632) conv_load(p, it1 / 3, it1 % 3, B);
        conv_compute(p, lds, it / 3, it % 3, A);
        if (it2 < 1632) conv_load(p, it2 / 3, it2 % 3, A);
        if (it1 < 1632) conv_compute(p, lds, it1 / 3, it1 % 3, B);
    }
    for (int it = G - 1 - blk; it < 544; it += G) dt_item(p, lds, it);
}

#define LDS_BARRIER() do { asm volatile("s_waitcnt lgkmcnt(0)" ::: "memory"); __builtin_amdgcn_s_barrier(); asm volatile("" ::: "memory"); } while (0)
__device__ __forceinline__ void item_done(const Params& p) {
    asm volatile("s_waitcnt vmcnt(0)" ::: "memory");
    __syncthreads();
    if (threadIdx.x == 0) __hip_atomic_fetch_add(p.ctr + 1, 1u, __ATOMIC_RELAXED, __HIP_MEMORY_SCOPE_AGENT);
}
struct SsdStage { bf16x8 B[2], C[2], BT[2], z, xc; float dt, ac; };
constexpr int L_BS = 0, L_CS = 17408, L_BTS = 34816, L_ZS = 53248, L_XL = 62464, L_XT = 71680, L_XDD = 80896, L_MX = 90112, L_HL = 99328, L_DTS = 116736, L_ACS = 116992;

__device__ __forceinline__ void ssd_stage_load(const Params& p, int r0, int hd, int g, int tid, SsdStage& s) {
    const int lane = tid & 63, wid = tid >> 6, ci = r0 >> 6;
    const bf16_t* xb = p.xbc + (size_t)r0 * XSB;
    const int rr = tid >> 4, cc = (tid & 15) * 8;
    s.B[0] = __builtin_nontemporal_load((const bf16x8*)(xb + (size_t)rr * XSB + 1024 + g * 128 + cc));
    s.B[1] = __builtin_nontemporal_load((const bf16x8*)(xb + (size_t)(rr + 32) * XSB + 1024 + g * 128 + cc));
    s.C[0] = __builtin_nontemporal_load((const bf16x8*)(xb + (size_t)rr * XSB + 1280 + g * 128 + cc));
    s.C[1] = __builtin_nontemporal_load((const bf16x8*)(xb + (size_t)(rr + 32) * XSB + 1280 + g * 128 + cc));
    const bf16_t* bt = p.BT + (size_t)(ci * 2 + g) * 8192;
    s.BT[0] = __builtin_nontemporal_load((const bf16x8*)(bt + tid * 8));
    s.BT[1] = __builtin_nontemporal_load((const bf16x8*)(bt + 4096 + tid * 8));
    s.z = __builtin_nontemporal_load((const bf16x8*)(p.h + (size_t)(r0 + (tid >> 3)) * HS + 3072 + hd * 64 + (tid & 7) * 8));
    s.xc = *(const bf16x8*)(xb + (size_t)lane * XSB + hd * 64 + wid * 8);
    s.dt = p.dtT[((size_t)ci * 16 + hd) * 64 + lane];
    s.ac = p.acT[((size_t)ci * 16 + hd) * 64 + lane];
}

__device__ __forceinline__ void ssd_item(const Params& p, LAS unsigned char* lds, int seq, int hd) {
    const int tid = threadIdx.x, lane = tid & 63, wid = __builtin_amdgcn_readfirstlane(tid >> 6), fr = lane & 15, fq = lane >> 4, lt = wid >> 1;
    const bool prompt = seq < 8;
    const int nch = prompt ? 64 : 1;
    const int rbase = prompt ? seq * 4096 : T_PROMPT + (seq - 8) * 64;
    const int g = hd >> 3;
    const float Dsk = p.d_skip[hd];
    f32x4 hT[4];
    float* hout = prompt ? p.out + O_SSMP + (size_t)(seq * 16 + hd) * 8192 : p.out + O_SSMS + (size_t)((seq - 8) * 16 + hd) * 8192;
    if (prompt) {
#pragma unroll
        for (int pt = 0; pt < 4; ++pt) hT[pt] = (f32x4){0.f, 0.f, 0.f, 0.f};
    } else {
        const float* h0 = p.state_ssm + (size_t)((seq - 8) * 16 + hd) * 8192;
#pragma unroll
        for (int pt = 0; pt < 4; ++pt) hT[pt] = *(const f32x4*)(h0 + (size_t)(pt * 16 + fr) * 128 + wid * 16 + fq * 4);
    }
    LAS bf16_t* xT = (LAS bf16_t*)(lds + L_XT); LAS bf16_t* xdd = (LAS bf16_t*)(lds + L_XDD);
    LAS float* dts = (LAS float*)(lds + L_DTS); LAS float* acs = (LAS float*)(lds + L_ACS);
    SsdStage sA, sB;
    ssd_stage_load(p, rbase, hd, g, tid, sA);
    ssd_stage_load(p, nch > 1 ? rbase + 64 : rbase, hd, g, tid, sB);
    auto chunk_body = [&](const int c, SsdStage& s0) __attribute__((always_inline)) {
        const int r0 = rbase + c * 64;
        {
            const int rr = tid >> 4, cc = (tid & 15) * 8;
            *(LAS bf16x8*)(lds + L_BS + (rr * 136 + cc) * 2) = s0.B[0];
            *(LAS bf16x8*)(lds + L_BS + ((rr + 32) * 136 + cc) * 2) = s0.B[1];
            *(LAS bf16x8*)(lds + L_CS + (rr * 136 + cc) * 2) = s0.C[0];
            *(LAS bf16x8*)(lds + L_CS + ((rr + 32) * 136 + cc) * 2) = s0.C[1];
            *(LAS bf16x8*)(lds + L_BTS + ((tid >> 3) * 72 + (tid & 7) * 8) * 2) = s0.BT[0];
            *(LAS bf16x8*)(lds + L_BTS + (((tid >> 3) + 64) * 72 + (tid & 7) * 8) * 2) = s0.BT[1];
            *(LAS bf16x8*)(lds + L_ZS + ((tid >> 3) * 72 + (tid & 7) * 8) * 2) = s0.z;
            *(LAS bf16x8*)(lds + L_XL + (lane * 72 + wid * 8) * 2) = s0.xc;
            if (wid == 0) { dts[lane] = s0.dt; acs[lane] = s0.ac; }
            const float ac63 = __shfl(s0.ac, 63);
            const float decl = __expf(ac63 - s0.ac) * s0.dt;
            float xf[8]; unpack8(s0.xc, xf);
#pragma unroll
            for (int j = 0; j < 8; ++j) {
                xT[(wid * 8 + j) * 72 + lane] = (bf16_t)s0.xc[j];
                xdd[(wid * 8 + j) * 72 + lane] = (bf16_t)(cvt_pk_bf16(xf[j] * decl, 0.f) & 0xffffu);
            }
#pragma unroll
            for (int pt = 0; pt < 4; ++pt) {
                u32x2 w; w.x = cvt_pk_bf16(hT[pt][0], hT[pt][1]); w.y = cvt_pk_bf16(hT[pt][2], hT[pt][3]);
                *(LAS u32x2*)(lds + L_HL + ((pt * 16 + fr) * 136 + wid * 16 + fq * 4) * 2) = w;
            }
        }
        const bool sig = prompt && c >= 4 && (c & 3) == 0;
        if (sig) asm volatile("s_waitcnt vmcnt(0)" ::: "memory");
        if (c + 2 < nch) ssd_stage_load(p, r0 + 128, hd, g, tid, s0);
        LDS_BARRIER();
        if (sig && tid == 0) __hip_atomic_fetch_add(p.bar + PCNT_OFF + seq * 16 + (c >> 2) - 1, 1u, __ATOMIC_RELAXED, __HIP_MEMORY_SCOPE_AGENT);
        bf16x8 Cf[4];
#pragma unroll
        for (int kk = 0; kk < 4; ++kk) Cf[kk] = *(const LAS bf16x8*)(lds + L_CS + ((lt * 16 + fr) * 136 + kk * 32 + fq * 8) * 2);
        const float ac_l = acs[lt * 16 + fr];
        const float ac63u = acs[63];
        {
            const int lidx = lt * 16 + fr;
#pragma unroll
            for (int i = 0; i < 2; ++i) {
                const int st = (wid & 1) * 2 + i;
                f32x4 cb = (f32x4){0.f, 0.f, 0.f, 0.f};
#pragma unroll
                for (int kk = 0; kk < 4; ++kk) {
                    const bf16x8 Bf = *(const LAS bf16x8*)(lds + L_BS + ((st * 16 + fr) * 136 + kk * 32 + fq * 8) * 2);
                    cb = MFMA16(Bf, Cf[kk], cb);
                }
                const f32x4 ac_s = *(const LAS f32x4*)(acs + st * 16 + fq * 4);
                const f32x4 dt_s = *(const LAS f32x4*)(dts + st * 16 + fq * 4);
                float m[4];
#pragma unroll
                for (int j = 0; j < 4; ++j) {
                    const int s = st * 16 + fq * 4 + j;
                    const float diff = fminf(ac_l - ac_s[j], 0.f);
                    m[j] = (s <= lidx) ? cb[j] * __expf(diff) * dt_s[j] : 0.f;
                }
                u32x2 w; w.x = cvt_pk_bf16(m[0], m[1]); w.y = cvt_pk_bf16(m[2], m[3]);
                *(LAS u32x2*)(lds + L_MX + (lidx * 72 + st * 16 + fq * 4) * 2) = w;
            }
        }
        LDS_BARRIER();
        {
            const float el = __expf(ac_l);
            float ss = 0.f;
#pragma unroll
            for (int i = 0; i < 2; ++i) {
                const int pt = (wid & 1) * 2 + i;
                f32x4 yd = (f32x4){0.f, 0.f, 0.f, 0.f}, yo = (f32x4){0.f, 0.f, 0.f, 0.f};
#pragma unroll
                for (int kk = 0; kk < 2; ++kk) {
                    const bf16x8 A = *(const LAS bf16x8*)(lds + L_XT + ((pt * 16 + fr) * 72 + kk * 32 + fq * 8) * 2);
                    const bf16x8 Bo = *(const LAS bf16x8*)(lds + L_MX + ((lt * 16 + fr) * 72 + kk * 32 + fq * 8) * 2);
                    yd = MFMA16(A, Bo, yd);
                }
#pragma unroll
                for (int kk = 0; kk < 4; ++kk) {
                    const bf16x8 A = *(const LAS bf16x8*)(lds + L_HL + ((pt * 16 + fr) * 136 + kk * 32 + fq * 8) * 2);
                    yo = MFMA16(A, Cf[kk], yo);
                }
                const u32x2 xs = *(const LAS u32x2*)(lds + L_XL + ((lt * 16 + fr) * 72 + pt * 16 + fq * 4) * 2);
                const u32x2 zz = *(const LAS u32x2*)(lds + L_ZS + ((lt * 16 + fr) * 72 + pt * 16 + fq * 4) * 2);
                const float xv[4] = {bf_lo(xs.x), bf_hi(xs.x), bf_lo(xs.y), bf_hi(xs.y)};
                const float zv[4] = {bf_lo(zz.x), bf_hi(zz.x), bf_lo(zz.y), bf_hi(zz.y)};
                float yz[4];
#pragma unroll
                for (int j = 0; j < 4; ++j) { const float y = yd[j] + el * yo[j] + Dsk * xv[j]; yz[j] = y * silu_f(zv[j]); ss += yz[j] * yz[j]; }
                u32x2 w; w.x = cvt_pk_bf16(yz[0], yz[1]); w.y = cvt_pk_bf16(yz[2], yz[3]);
                bf16_t* yzp = p.h + (size_t)(r0 + lt * 16 + fr) * HS + 3072 + hd * 64 + pt * 16 + fq * 4;
                __hip_atomic_store((unsigned long long*)yzp, ((unsigned long long)w.y << 32) | w.x, __ATOMIC_RELAXED, __HIP_MEMORY_SCOPE_AGENT);
            }
            ss += __shfl_xor(ss, 16); ss += __shfl_xor(ss, 32);
            if (fq == 0) atomicAdd(p.ssq + r0 + lt * 16 + fr, ss);
            const float cd = __expf(ac63u);
            bf16x8 BTf[2];
#pragma unroll
            for (int kk = 0; kk < 2; ++kk) BTf[kk] = *(const LAS bf16x8*)(lds + L_BTS + ((wid * 16 + fr) * 72 + kk * 32 + fq * 8) * 2);
#pragma unroll
            for (int pt = 0; pt < 4; ++pt) {
                f32x4 acc = hT[pt] * cd;
#pragma unroll
                for (int kk = 0; kk < 2; ++kk) {
                    const bf16x8 Bo = *(const LAS bf16x8*)(lds + L_XDD + ((pt * 16 + fr) * 72 + kk * 32 + fq * 8) * 2);
                    acc = MFMA16(BTf[kk], Bo, acc);
                }
                hT[pt] = acc;
            }
        }
        LDS_BARRIER();
    };
#pragma unroll 1
    for (int c = 0; c < nch; c += 2) {
        chunk_body(c, sA);
        if (c + 1 < nch) chunk_body(c + 1, sB);
    }
#pragma unroll
    for (int pt = 0; pt < 4; ++pt) *(f32x4*)(hout + (size_t)(pt * 16 + fr) * 128 + wid * 16 + fq * 4) = hT[pt];
    if (!prompt) item_done(p);
    else {
        asm volatile("s_waitcnt vmcnt(0)" ::: "memory");
        __syncthreads();
        if (tid == 0) __hip_atomic_fetch_add(p.bar + PCNT_OFF + seq * 16 + 15, 1u, __ATOMIC_RELAXED, __HIP_MEMORY_SCOPE_AGENT);
    }
}

constexpr int G_VS = 0, G_WS = 34816, G_VNT = 69632, G_MU = 104448, G_RS = 104960;
__device__ __forceinline__ void gmlp_item(const Params& p, LAS unsigned char* lds, int item) {
    const int tid = threadIdx.x, lane = tid & 63, wid = __builtin_amdgcn_readfirstlane(tid >> 6), fr = lane & 15, fq = lane >> 4;
    const bool sample = item >= 2048;
    const int hd = item & 7;
    const int r0 = sample ? T_PROMPT + ((item - 2048) >> 3) * 128 : (item >> 3) * 128;
    LAS bf16_t* vnT = (LAS bf16_t*)(lds + G_VNT);
    LAS float* mus = (LAS float*)(lds + G_MU); LAS float* rss = (LAS float*)(lds + G_RS);
    const int wt = sample ? (wid & 3) : wid;
    const int kk0 = sample ? ((wid >> 2) * 2) : 0;
    const int nkk = sample ? 2 : (wid < 4 ? 2 : 4);
    const int rr = tid >> 4, cc = (tid & 15) * 8;
    bf16_t* hb = p.h + (size_t)(r0 + rr) * HS + hd * 128 + cc;
    bf16x8 vv[4], uu[4], gg[4], ww[4];
#pragma unroll
    for (int i = 0; i < 4; ++i) {
        vv[i] = __builtin_nontemporal_load((const bf16x8*)(hb + (size_t)i * 32 * HS + 1024));
        uu[i] = __builtin_nontemporal_load((const bf16x8*)(hb + (size_t)i * 32 * HS));
        gg[i] = __builtin_nontemporal_load((const bf16x8*)(hb + (size_t)i * 32 * HS + 2048));
        ww[i] = *(const bf16x8*)(p.Wm + ((size_t)hd * 128 + rr + 32 * i) * 128 + cc);
    }
    const f32x4 sp0 = *(const f32x4*)(p.stats + (size_t)r0 * 32 + tid * 4), sp1 = *(const f32x4*)(p.stats + (size_t)r0 * 32 + 2048 + tid * 4);
#pragma unroll
    for (int i = 0; i < 4; ++i) {
        *(LAS bf16x8*)(lds + G_VS + ((rr + 32 * i) * 136 + cc) * 2) = vv[i];
        *(LAS bf16x8*)(lds + G_WS + ((rr + 32 * i) * 136 + cc) * 2) = ww[i];
    }
    {
        float s0 = sp0[0] + sp0[2], q0 = sp0[1] + sp0[3], s1 = sp1[0] + sp1[2], q1 = sp1[1] + sp1[3];
#pragma unroll
        for (int o = 1; o < 8; o <<= 1) { s0 += __shfl_xor(s0, o); q0 += __shfl_xor(q0, o); s1 += __shfl_xor(s1, o); q1 += __shfl_xor(q1, o); }
        if ((tid & 7) == 0) {
            const float m0 = s0 * (1.f / 1024.f), m1 = s1 * (1.f / 1024.f);
            mus[tid >> 3] = m0; rss[tid >> 3] = rsqrtf(fmaxf(q0 * (1.f / 1024.f) - m0 * m0, 0.f) + EPS);
            mus[64 + (tid >> 3)] = m1; rss[64 + (tid >> 3)] = rsqrtf(fmaxf(q1 * (1.f / 1024.f) - m1 * m1, 0.f) + EPS);
        }
    }
    LDS_BARRIER();
#pragma unroll
    for (int dd = 0; dd < 2; ++dd) {
        const int dg = wid + 8 * dd;
        float lw[8], lb[8];
#pragma unroll
        for (int q = 0; q < 2; ++q) {
            const f32x4 a = *(const f32x4*)(p.ln_w + hd * 128 + dg * 8 + q * 4), b = *(const f32x4*)(p.ln_b + hd * 128 + dg * 8 + q * 4);
#pragma unroll
            for (int j = 0; j < 4; ++j) { lw[q * 4 + j] = a[j]; lb[q * 4 + j] = b[j]; }
        }
        const int slot0 = (dg >> 2) * 32 + (dg & 3) * 4;
#pragma unroll
        for (int q = 0; q < 2; ++q) {
            const int s = lane + 64 * q;
            const float mu = mus[s], rs = rss[s];
            float v[8]; unpack8(*(const LAS bf16x8*)(lds + G_VS + (s * 136 + dg * 8) * 2), v);
#pragma unroll
            for (int j = 0; j < 8; ++j) v[j] = (v[j] - mu) * rs * lw[j] + lb[j];
#pragma unroll
            for (int j = 0; j < 8; ++j) vnT[(slot0 + (j >> 2) * 16 + (j & 3)) * 136 + s] = (bf16_t)(cvt_pk_bf16(v[j], 0.f) & 0xffffu);
            if (sample) {
                float* vo = p.out + O_VS + (size_t)(r0 + s - T_PROMPT) * 1024 + hd * 128 + dg * 8;
                *(f32x4*)(vo) = (f32x4){v[0], v[1], v[2], v[3]};
                *(f32x4*)(vo + 4) = (f32x4){v[4], v[5], v[6], v[7]};
            }
        }
    }
    LDS_BARRIER();
    {
        bf16x8 Wf[4];
#pragma unroll
        for (int kk = 0; kk < 4; ++kk) Wf[kk] = *(const LAS bf16x8*)(lds + G_WS + ((wt * 16 + fr) * 136 + (kk < nkk ? kk : 0) * 32 + fq * 8) * 2);
        const float bias = p.gbs[hd * 128 + wt * 16 + fr];
#pragma unroll
        for (int q = 0; q < 4; ++q) {
#pragma unroll
            for (int hf = 0; hf < 2; ++hf) {
                f32x4 acc = (f32x4){0.f, 0.f, 0.f, 0.f};
#pragma unroll
                for (int kk = 0; kk < 4; ++kk) {
                    if (kk < nkk) {
                        const bf16x8 A = *(const LAS bf16x8*)(lds + G_VNT + ((q * 32 + hf * 16 + fr) * 136 + (kk0 + kk) * 32 + fq * 8) * 2);
                        acc = MFMA16(A, Wf[kk], acc);
                    }
                }
                u32x2 w; w.x = cvt_pk_bf16(acc[0] + bias, acc[1] + bias); w.y = cvt_pk_bf16(acc[2] + bias, acc[3] + bias);
                *(LAS u32x2*)(lds + G_VS + ((wid * 16 + fr) * 136 + q * 32 + fq * 8 + hf * 4) * 2) = w;
            }
        }
    }
    LDS_BARRIER();
#pragma unroll
    for (int i = 0; i < 4; ++i) {
        float mv[8], uv[8], gv[8], o[8];
        unpack8(*(const LAS bf16x8*)(lds + G_VS + ((rr + 32 * i) * 136 + cc) * 2), mv);
        unpack8(uu[i], uv); unpack8(gg[i], gv);
#pragma unroll
        for (int j = 0; j < 8; ++j) o[j] = uv[j] * mv[j] * silu_f(gv[j]);
        u32x4 w; w.x = cvt_pk_bf16(o[0], o[1]); w.y = cvt_pk_bf16(o[2], o[3]); w.z = cvt_pk_bf16(o[4], o[5]); w.w = cvt_pk_bf16(o[6], o[7]);
        __hip_atomic_store((unsigned long long*)(hb + (size_t)i * 32 * HS), ((unsigned long long)w.y << 32) | w.x, __ATOMIC_RELAXED, __HIP_MEMORY_SCOPE_AGENT);
        __hip_atomic_store((unsigned long long*)(hb + (size_t)i * 32 * HS + 4), ((unsigned long long)w.w << 32) | w.z, __ATOMIC_RELAXED, __HIP_MEMORY_SCOPE_AGENT);
    }
    if (sample) item_done(p);
    else {
        asm volatile("s_waitcnt vmcnt(0)" ::: "memory");
        __syncthreads();
        const int c128 = item >> 3;
        if (tid == 0) __hip_atomic_fetch_add(p.bar + PCNT_OFF + (c128 >> 5) * 16 + ((c128 & 31) >> 1), 1u, __ATOMIC_RELAXED, __HIP_MEMORY_SCOPE_AGENT);
    }
}

__device__ __forceinline__ void phase2b(const Params& p, LAS unsigned char* lds) {
    LAS int* sItem = (LAS int*)(lds + LDS_ITEM_OFF);
    int nxt = 0;
    if (threadIdx.x == 0) nxt = (int)atomicAdd(p.ctr, 1u);
    for (;;) {
        __syncthreads();
        if (threadIdx.x == 0) *sItem = nxt;
        __syncthreads();
        const int it = *sItem;
        if (it >= 640) break;
        if (threadIdx.x == 0 && it >= 128) nxt = (int)atomicAdd(p.ctr, 1u);
        const int seq = it < 128 ? (it >> 4) : 8 + ((it - 128) >> 4);
        ssd_item(p, lds, seq, it & 15);
        if (threadIdx.x == 0 && it < 128) nxt = (int)atomicAdd(p.ctr, 1u);
    }
    if (threadIdx.x == 0) nxt = (int)atomicAdd(p.ctr + 3, 1u);
    for (;;) {
        __syncthreads();
        if (threadIdx.x == 0) *sItem = nxt;
        __syncthreads();
        const int it = *sItem;
        if (it >= 2176) break;
        if (threadIdx.x == 0) nxt = (int)atomicAdd(p.ctr + 3, 1u);
        gmlp_item(p, lds, it < 128 ? 2048 + it : it - 128);
    }
    const int xq = (int)((unsigned)__builtin_amdgcn_s_getreg((3 << 11) | 20) & 7u);
    for (int qq = 0; qq < 8; ++qq) {
        const int q = (xq + qq) & 7;
        for (;;) {
            __syncthreads();
            if (threadIdx.x == 0) *sItem = (int)atomicAdd(p.ctr + 8 + q, 1u);
            __syncthreads();
            const int k = *sItem;
            if (k >= 68) break;
            const int idx = k >> 2, pn = k & 3;
            const int pm = idx == 0 ? 128 + q : ((q - (idx - 1)) & 7) * 16 + (idx - 1);
            if (threadIdx.x == 0) {
                unsigned* cnt = idx == 0 ? p.ctr + 1 : p.bar + PCNT_OFF + pm;
                const unsigned need = idx == 0 ? 640u : 32u;
                unsigned sp = 0;
                while (__hip_atomic_load(cnt, __ATOMIC_RELAXED, __HIP_MEMORY_SCOPE_AGENT) < need) { __builtin_amdgcn_s_sleep(8); if (++sp > (1u << 22)) break; }
                __builtin_amdgcn_fence(__ATOMIC_ACQUIRE, "agent");
                asm volatile("s_waitcnt vmcnt(0)" ::: "memory");
            }
            __syncthreads();
            gemm_phase<2, true, true>(p, lds, pm, pn);
        }
    }
}

__device__ __forceinline__ void phase4(const Params& p, int first_row) {
    const int tid = threadIdx.x, lane = tid & 63, wid = tid >> 6;
    const int G = gridDim.x;
    f32x4 nw[4];
#pragma unroll
    for (int i = 0; i < 4; ++i) nw[i] = *(const f32x4*)(p.norm_f_w + i * 256 + lane * 4);
    constexpr int RP = 1;
    for (int row0 = first_row + blockIdx.x * 8 + wid; row0 < T_ALL; row0 += G * 8 * RP) {
        f32x4 v[RP][4]; f32x4 fv[RP][4];
#pragma unroll
        for (int r = 0; r < RP; ++r) {
            const int row = row0 + r * G * 8;
            if (row < T_ALL) {
                const float* o = p.out + (size_t)row * DM;
                const float* fp = p.fpart + (size_t)row * 16;
#pragma unroll
                for (int i = 0; i < 4; ++i) { v[r][i] = *(const f32x4*)(o + i * 256 + lane * 4); fv[r][i] = *(const f32x4*)(fp + i * 4); }
            }
        }
#pragma unroll
        for (int r = 0; r < RP; ++r) {
            const int row = row0 + r * G * 8;
            if (row < T_ALL) {
                float ss = 0.f;
#pragma unroll
                for (int k = 0; k < 4; ++k) ss += (fv[r][k][0] + fv[r][k][1]) + (fv[r][k][2] + fv[r][k][3]);
                const float rs = rsqrtf(ss * (1.f / 1024.f) + EPS);
                float* o = p.out + (size_t)row * DM;
#pragma unroll
                for (int i = 0; i < 4; ++i) *(f32x4*)(o + i * 256 + lane * 4) = v[r][i] * rs * nw[i];
            }
        }
    }
}


#define XB_TMO      128
#define XB_XCNT(j)  (256  + 64 * (j))
#define XB_XSUB(j)  (1280 + 64 * (j))
#define XB_XGEN(j)  (2304 + 64 * (j))
#define XB_TOP      3328
#define XB_TOPGEN   3392
#define XCD_BAR_WORDS 3456
#define XB_SPIN_CAP (1u << 18)
__device__ __forceinline__ unsigned xb_ld(unsigned* p)              { return __hip_atomic_load(p, __ATOMIC_RELAXED, __HIP_MEMORY_SCOPE_AGENT); }
__device__ __forceinline__ unsigned xb_add(unsigned* p, unsigned v) { return __hip_atomic_fetch_add(p, v, __ATOMIC_RELAXED, __HIP_MEMORY_SCOPE_AGENT); }
__device__ __forceinline__ unsigned xb_xcc_id() { return (unsigned)__builtin_amdgcn_s_getreg((3 << 11) | 20) & 0xFu; }
#define XB_SPIN(cond, bar) do { unsigned _sp = 0; while (cond) { __builtin_amdgcn_s_sleep(1); \
    if ((++_sp & 255u) == 0u) { if (xb_ld(&(bar)[XB_TMO])) break; if (_sp > XB_SPIN_CAP) { atomicAdd(&(bar)[XB_TMO], 1u); break; } } } } while (0)
struct XcdBarrier { unsigned* bar; unsigned x; volatile LAS unsigned* st; };
__device__ __forceinline__ XcdBarrier xcd_barrier_post(unsigned* bar, volatile LAS unsigned* st) {
    XcdBarrier b; b.bar = bar; b.x = xb_xcc_id(); b.st = st;
    if (threadIdx.x == 0) (void)xb_add(&bar[XB_XCNT(b.x)], 1u);
    return b;
}
__device__ __forceinline__ void xcd_barrier_complete(unsigned* bar, unsigned x, unsigned& nloc, unsigned& nx) {
    const unsigned G = gridDim.x * gridDim.y * gridDim.z;
    unsigned sum, cnt, mine, sp = 0u;
    for (;;) {
        sum = 0u; cnt = 0u; mine = 0u;
#pragma unroll
        for (unsigned j = 0; j < 16; ++j) { const unsigned c = xb_ld(&bar[XB_XCNT(j)]); sum += c; cnt += (c > 0u) ? 1u : 0u; mine = (j == x) ? c : mine; }
        if (sum == G) break;
        __builtin_amdgcn_s_sleep(1);
        if ((++sp & 255u) == 0u) { if (xb_ld(&bar[XB_TMO])) break; if (sp > XB_SPIN_CAP) { atomicAdd(&bar[XB_TMO], 1u); break; } }
    }
    nloc = mine > 0u ? mine : 1u; nx = cnt > 0u ? cnt : 1u;
}
__device__ __forceinline__ void xcd_barrier(const XcdBarrier& b) {
    asm volatile("s_waitcnt vmcnt(0)" ::: "memory");
    __syncthreads();
    if (threadIdx.x == 0) {
        unsigned* bar = b.bar;
        __builtin_amdgcn_s_waitcnt(0);
        unsigned nloc = b.st[0], nx = b.st[1];
        if (nloc == 0u) { xcd_barrier_complete(bar, b.x, nloc, nx); b.st[0] = nloc; b.st[1] = nx; }
        const unsigned old = xb_add(&bar[XB_XSUB(b.x)], 1u);
        const unsigned gen = old / nloc;
        if (old + 1u == (gen + 1u) * nloc) {
            __builtin_amdgcn_fence(__ATOMIC_RELEASE, "agent");
            asm volatile("s_waitcnt vmcnt(0)" ::: "memory");
            const unsigned og = xb_add(&bar[XB_TOP], 1u);
            const unsigned tg = og / nx;
            if (og + 1u == (tg + 1u) * nx) xb_add(&bar[XB_TOPGEN], 1u);
            else XB_SPIN(xb_ld(&bar[XB_TOPGEN]) == tg, bar);
            __builtin_amdgcn_fence(__ATOMIC_ACQUIRE, "agent");
            xb_add(&bar[XB_XGEN(b.x)], 1u);
            asm volatile("s_waitcnt vmcnt(0)" ::: "memory");
        } else {
            XB_SPIN(xb_ld(&bar[XB_XGEN(b.x)]) == gen, bar);
            __builtin_amdgcn_fence(__ATOMIC_ACQUIRE, "agent");
            asm volatile("s_waitcnt vmcnt(0)" ::: "memory");
        }
    }
    __syncthreads();
}

#if ONE_LAUNCH
__global__ void __launch_bounds__(512) mega_kernel(Params p) {
    extern __shared__ __attribute__((aligned(16))) unsigned char smem[];
    LAS unsigned char* lds = (LAS unsigned char*)smem;
    volatile LAS unsigned* st = (volatile LAS unsigned*)(lds + LDS_ITEM_OFF + 16);
    if (threadIdx.x == 0) { st[0] = 0u; st[1] = 0u; }
    __syncthreads();
    XcdBarrier xb = xcd_barrier_post(p.bar, st);
#if DIAG
    unsigned long long* ts = (unsigned long long*)(p.ctr + 64);
#define STAMP(i) do { if (blockIdx.x == 0 && threadIdx.x == 0) ts[i] = __builtin_amdgcn_s_memrealtime(); } while (0)
    xcd_barrier(xb);
#else
#define STAMP(i) do { } while (0)
#endif
    STAMP(0);
    phase0(p, lds); xcd_barrier(xb); STAMP(1);
    gemm_phase<1>(p, lds); phase1_tail(p, lds); xcd_barrier(xb); STAMP(2);
    phase2a(p, lds); xcd_barrier(xb); STAMP(3);
    phase2b(p, lds);
#if DIAG
    xcd_barrier(xb); STAMP(4);
    xcd_barrier(xb);
    {
#if DIAG == 3
        float ta = (float)p.ctr[40] * 0.0001f, tb = (float)p.ctr[41] * 0.01f * 5.f;
#elif DIAG == 2
        float ta = (float)p.ctr[36] * 0.01f / 128.f, tb = (float)p.ctr[37] * 0.01f / 2176.f;
        ta = exp2f(rintf(log2f(ta) * 12.f) / 12.f); tb = exp2f(rintf(log2f(tb) * 12.f) / 12.f) * 30.f;
#else
        float ta = (float)(ts[DIAG_A + 1] - ts[DIAG_A]) * 0.01f, tb = (float)(ts[DIAG_B + 1] - ts[DIAG_B]) * 0.01f;
        ta *= 0.01f;
#endif
        if (blockIdx.x == 0 && threadIdx.x == 0) p.out[0] += ta;
        for (int i = blockIdx.x * 512 + threadIdx.x; i < 2097152; i += gridDim.x * 512) p.out[O_VS + i] += tb * 0.001f;
    }
#endif
}
#else
template <int PH> __global__ void __launch_bounds__(512) phase_kernel(Params p) {
    extern __shared__ __attribute__((aligned(16))) unsigned char smem[];
    LAS unsigned char* lds = (LAS unsigned char*)smem;
    if (PH == 0) phase0(p, lds);
    if (PH == 1) gemm_phase<1>(p, lds);
    if (PH == 2) phase2a(p, lds);
    if (PH == 3) phase2b(p, lds);
    if (PH == 4) gemm_phase<2, false, false>(p, lds);
    if (PH == 5) phase4(p, 0);
}
#endif

extern "C" void kernel_launch(void* const* d_in, const int* in_sizes, int n_in, void* d_out, int out_size, void* d_ws, size_t ws_size, hipStream_t stream) {
    static int grid = 0;
    if (grid == 0) {
        if (n_in != 18 || ws_size < WS_END) { fprintf(stderr, "kernel_launch: need 18 inputs and >= %zu bytes of workspace (got %d, %zu)\n", (size_t)WS_END, n_in, ws_size); grid = -1; return; }
        int dev = 0, cus = 0, per_cu = 0;
        hipGetDevice(&dev);
        hipDeviceGetAttribute(&cus, hipDeviceAttributeMultiprocessorCount, dev);
#if ONE_LAUNCH
        hipFuncSetAttribute((const void*)mega_kernel, hipFuncAttributeMaxDynamicSharedMemorySize, LDS_BYTES);
        hipOccupancyMaxActiveBlocksPerMultiprocessor(&per_cu, (const void*)mega_kernel, 512, LDS_BYTES);
        if (per_cu < 1) { fprintf(stderr, "kernel_launch: occupancy query says %d blocks per CU\n", per_cu); per_cu = 1; }
        grid = cus * per_cu;
#else
        hipFuncSetAttribute((const void*)phase_kernel<0>, hipFuncAttributeMaxDynamicSharedMemorySize, LDS_BYTES);
        hipFuncSetAttribute((const void*)phase_kernel<1>, hipFuncAttributeMaxDynamicSharedMemorySize, LDS_BYTES);
        hipFuncSetAttribute((const void*)phase_kernel<2>, hipFuncAttributeMaxDynamicSharedMemorySize, LDS_BYTES);
        hipFuncSetAttribute((const void*)phase_kernel<3>, hipFuncAttributeMaxDynamicSharedMemorySize, LDS_BYTES);
        hipFuncSetAttribute((const void*)phase_kernel<4>, hipFuncAttributeMaxDynamicSharedMemorySize, LDS_BYTES);
        hipFuncSetAttribute((const void*)phase_kernel<5>, hipFuncAttributeMaxDynamicSharedMemorySize, LDS_BYTES);
        (void)per_cu;
        grid = cus;
#endif
    }
    if (grid < 0) return;
    Params p{};
    p.x_prompt = (const float*)d_in[0]; p.x_sample = (const float*)d_in[1]; p.state_ssm = (const float*)d_in[2]; p.state_conv = (const float*)d_in[3];
    p.norm_in_w = (const float*)d_in[4]; p.w_in = (const float*)d_in[5]; p.ln_w = (const float*)d_in[6]; p.ln_b = (const float*)d_in[7];
    p.gws = (const float*)d_in[8]; p.gbs = (const float*)d_in[9]; p.conv_w = (const float*)d_in[10]; p.conv_b = (const float*)d_in[11];
    p.dt_bias = (const float*)d_in[12]; p.a_log = (const float*)d_in[13]; p.d_skip = (const float*)d_in[14]; p.ssm_norm_w = (const float*)d_in[15];
    p.w_out = (const float*)d_in[16]; p.norm_f_w = (const float*)d_in[17];
    p.out = (float*)d_out;
    unsigned char* ws = (unsigned char*)d_ws;
    p.h = (bf16_t*)(ws + WS_H); p.xn = (bf16_t*)(ws + WS_XN); p.WinT = (bf16_t*)(ws + WS_WINT); p.WoutT = (bf16_t*)(ws + WS_WOUTT);
    p.WdtT = (bf16_t*)(ws + WS_WDTT); p.Wm = (bf16_t*)(ws + WS_WM); p.BT = (bf16_t*)(ws + WS_BT);
    p.xbc = (bf16_t*)d_out;
    p.stats = (float*)(ws + WS_STATS); p.ssq = (float*)(ws + WS_SSQ); p.fpart = (float*)(ws + WS_FPART);
    p.dtT = (float*)(ws + WS_DTT); p.acT = (float*)(ws + WS_ACT); p.ctr = (unsigned*)(ws + WS_CTR); p.bar = (unsigned*)(ws + WS_BAR); p.dtraw = (float*)(ws + WS_DTRAW);
#if ONE_LAUNCH
    if (hipMemsetAsync(ws + WS_CTR, 0, 1024 + 16384, stream) != hipSuccess) { fprintf(stderr, "kernel_launch: memset of barrier words failed\n"); return; }
    void* args[] = {&p};
    hipError_t e = hipLaunchCooperativeKernel((const void*)mega_kernel, dim3(grid), dim3(512), args, LDS_BYTES, stream);
    if (e != hipSuccess) fprintf(stderr, "cooperative launch failed: %s (grid %d)\n", hipGetErrorString(e), grid);
#else
    hipLaunchKernelGGL(phase_kernel<0>, dim3(grid), dim3(512), LDS_BYTES, stream, p);
    hipLaunchKernelGGL(phase_kernel<1>, dim3(grid), dim3(512), LDS_BYTES, stream, p);
    hipLaunchKernelGGL(phase_kernel<2>, dim3(grid), dim3(512), LDS_BYTES, stream, p);
    hipLaunchKernelGGL(phase_kernel<3>, dim3(grid), dim3(512), LDS_BYTES, stream, p);
    hipLaunchKernelGGL(phase_kernel<4>, dim3(grid), dim3(512), LDS_BYTES, stream, p);
    hipLaunchKernelGGL(phase_kernel<5>, dim3(grid), dim3(512), LDS_BYTES, stream, p);
#endif
}
```

```cpp
#include <hip/hip_runtime.h>
#include <hip/hip_cooperative_groups.h>
#include <cstdio>
namespace cg = cooperative_groups;

#ifndef ONE_LAUNCH
#define ONE_LAUNCH 1
#endif

#ifndef DIAG
#define DIAG 0
#endif
#ifndef DIAG_A
#define DIAG_A 0
#endif
#ifndef DIAG_B
#define DIAG_B 1
#endif
#define LAS __attribute__((address_space(3)))
typedef unsigned short bf16_t;
typedef short bf16x8 __attribute__((ext_vector_type(8)));
typedef float f32x4 __attribute__((ext_vector_type(4)));
typedef float f32x2 __attribute__((ext_vector_type(2)));
typedef unsigned u32x4 __attribute__((ext_vector_type(4)));
typedef unsigned u32x2 __attribute__((ext_vector_type(2)));

constexpr int T_ALL = 34816, T_PROMPT = 32768, DM = 1024, HS = 5632  , DIN = 5648;
constexpr int XS = 1536;
constexpr int XSB = 2048;
constexpr float EPS = 1e-5f;
constexpr int LDS_BYTES = 131072 + 1024;
constexpr int LDS_ITEM_OFF = 131072;

constexpr size_t O_Y = 0, O_SSMP = 35651584, O_CONVP = 36700160, O_SSMS = 36737024, O_CONVS = 40931328, O_VS = 41078784;

struct Params {
    const float* x_prompt; const float* x_sample; const float* state_ssm; const float* state_conv;
    const float* norm_in_w; const float* w_in; const float* ln_w; const float* ln_b; const float* gws; const float* gbs;
    const float* conv_w; const float* conv_b; const float* dt_bias; const float* a_log; const float* d_skip; const float* ssm_norm_w;
    const float* w_out; const float* norm_f_w;
    float* out;
    bf16_t* h; bf16_t* xn; bf16_t* WinT; bf16_t* WoutT; bf16_t* WdtT; bf16_t* Wm; bf16_t* BT; bf16_t* xbc;
    float* stats; float* ssq; float* fpart; float* dtraw; float* dtT; float* acT; unsigned* ctr; unsigned* bar;
};

constexpr size_t WS_H = 0;
constexpr size_t WS_XN = WS_H + (size_t)T_ALL * HS * 2;
constexpr size_t WS_WINT = WS_XN + (size_t)T_ALL * DM * 2;
constexpr size_t WS_WOUTT = WS_WINT + (size_t)5632 * 1024 * 2;
constexpr size_t WS_WDTT = WS_WOUTT + (size_t)1024 * 2048 * 2;
constexpr size_t WS_WM = WS_WDTT + (size_t)16 * 1024 * 2;
constexpr size_t WS_BT = WS_WM + (size_t)8 * 128 * 128 * 2;
constexpr size_t WS_STATS = WS_BT + (size_t)544 * 2 * 128 * 64 * 2;
constexpr size_t WS_SSQ = WS_STATS + (size_t)T_ALL * 32 * 4;
constexpr size_t WS_FPART = WS_SSQ + (size_t)T_ALL * 4;
constexpr size_t WS_DTT = WS_FPART + (size_t)T_ALL * 16 * 4;
constexpr size_t WS_ACT = WS_DTT + (size_t)T_ALL * 16 * 4;
constexpr size_t WS_CTR = WS_ACT + (size_t)T_ALL * 16 * 4;
constexpr size_t WS_BAR = WS_CTR + 1024;
constexpr size_t WS_DTRAW = WS_BAR + 16384;
constexpr size_t WS_END = WS_DTRAW + (size_t)T_ALL * 16 * 4;

__device__ __forceinline__ unsigned cvt_pk_bf16(float lo, float hi) { unsigned r; asm("v_cvt_pk_bf16_f32 %0, %1, %2" : "=v"(r) : "v"(lo), "v"(hi)); return r; }
__device__ __forceinline__ float bf_lo(unsigned w) { return __uint_as_float(w << 16); }
__device__ __forceinline__ float bf_hi(unsigned w) { return __uint_as_float(w & 0xffff0000u); }
__device__ __forceinline__ float silu_f(float x) { return x * __builtin_amdgcn_rcpf(1.f + __expf(-x)); }
__device__ __forceinline__ const float* xrow_ptr(const Params& p, int row) {
    return row < T_PROMPT ? p.x_prompt + (size_t)row * DM : p.x_sample + (size_t)(row - T_PROMPT) * DM;
}
#define MFMA16(a, b, c) __builtin_amdgcn_mfma_f32_16x16x32_bf16((a), (b), (c), 0, 0, 0)

__device__ __forceinline__ void transpose_tile(const float* __restrict__ src, int ldn, int k0, int n0, const float* __restrict__ scale, int s0,
                                               bf16_t* __restrict__ dst, int ldk, int kd0, LAS float* tl) {
    const int tid = threadIdx.x;
    __syncthreads();
    {
        const int r = tid >> 4, c4 = tid & 15;
#pragma unroll
        for (int i = 0; i < 2; ++i) {
            const int k = r + 32 * i;
            f32x4 v = *(const f32x4*)(src + (size_t)(k0 + k) * ldn + n0 + c4 * 4);
            const float sc = scale ? scale[s0 + k] : 1.f;
            tl[k * 65 + c4 * 4 + 0] = v[0] * sc; tl[k * 65 + c4 * 4 + 1] = v[1] * sc; tl[k * 65 + c4 * 4 + 2] = v[2] * sc; tl[k * 65 + c4 * 4 + 3] = v[3] * sc;
        }
    }
    __syncthreads();
    {
        const int n = tid >> 3, kg = tid & 7;
        float f[8];
#pragma unroll
        for (int j = 0; j < 8; ++j) f[j] = tl[(kg * 8 + j) * 65 + n];
        u32x4 w; w.x = cvt_pk_bf16(f[0], f[1]); w.y = cvt_pk_bf16(f[2], f[3]); w.z = cvt_pk_bf16(f[4], f[5]); w.w = cvt_pk_bf16(f[6], f[7]);
        *(u32x4*)(dst + (size_t)(n0 + n) * ldk + kd0 + kg * 8) = w;
    }
}

__device__ __forceinline__ void phase0(const Params& p, LAS unsigned char* lds) {
    const int tid = threadIdx.x, lane = tid & 63, wid = tid >> 6;
    const int G = gridDim.x, blk = blockIdx.x;
    for (int i = blk * 512 + tid; i < T_ALL; i += G * 512) p.ssq[i] = 0.f;
    for (int i = blk * 512 + tid; i < 16 * 1024; i += G * 512) {
        const int j = i >> 10, k = i & 1023;
        p.WdtT[i] = (bf16_t)(cvt_pk_bf16(p.w_in[(size_t)k * DIN + 5632 + j] * p.norm_in_w[k], 0.f) & 0xffffu);
    }
    for (int i = blk * 512 + tid; i < 8 * 128 * 128; i += G * 512) {
        const int t = (i >> 7) & 127, s = i & 127;
        float v = p.gws[i]; if ((s >> 6) > (t >> 6)) v = 0.f;
        p.Wm[i] = (bf16_t)(cvt_pk_bf16(v, 0.f) & 0xffffu);
    }
    LAS float* tl = (LAS float*)lds;
    for (int base = blk * 4; base < 1920; base += G * 4) {
        const float* srcp[4]; const float* scp[4]; bf16_t* dstp[4]; int ldn[4], ldk[4];
#pragma unroll
        for (int t = 0; t < 4; ++t) {
            const int ti = base + t;
            if (ti < 1408) {
                const int kt = ti / 88, nt_ = ti % 88;
                srcp[t] = p.w_in + (size_t)(kt * 64) * DIN + nt_ * 64; ldn[t] = DIN; scp[t] = p.norm_in_w + kt * 64;
                dstp[t] = p.WinT + (size_t)(nt_ * 64) * 1024 + kt * 64; ldk[t] = 1024;
            } else {
                const int t2 = ti - 1408, kt = t2 >> 4, nt_ = t2 & 15, k0 = kt * 64;
                srcp[t] = p.w_out + (size_t)k0 * 1024 + nt_ * 64; ldn[t] = 1024;
                scp[t] = k0 >= 1024 ? p.ssm_norm_w + (k0 - 1024) : nullptr;
                dstp[t] = p.WoutT + (size_t)(nt_ * 64) * 2048 + (k0 >= 1024 ? k0 - 1024 : k0 + 1024);
                ldk[t] = 2048;
            }
        }
        f32x4 v[4][2]; float sc[4][2];
        {
            const int r = tid >> 4, c4 = tid & 15;
#pragma unroll
            for (int t = 0; t < 4; ++t)
                if (base + t < 1920) {
#pragma unroll
                    for (int i = 0; i < 2; ++i) {
                        v[t][i] = *(const f32x4*)(srcp[t] + (size_t)(r + 32 * i) * ldn[t] + c4 * 4);
                        sc[t][i] = scp[t] ? scp[t][r + 32 * i] : 1.f;
                    }
                }
            __syncthreads();
#pragma unroll
            for (int t = 0; t < 4; ++t)
                if (base + t < 1920) {
#pragma unroll
                    for (int i = 0; i < 2; ++i) {
                        LAS float* d = tl + t * (64 * 65) + (r + 32 * i) * 65 + c4 * 4;
                        d[0] = v[t][i][0] * sc[t][i]; d[1] = v[t][i][1] * sc[t][i]; d[2] = v[t][i][2] * sc[t][i]; d[3] = v[t][i][3] * sc[t][i];
                    }
                }
        }
        __syncthreads();
        {
            const int n = tid >> 3, kg = tid & 7;
#pragma unroll
            for (int t = 0; t < 4; ++t)
                if (base + t < 1920) {
                    float f[8];
#pragma unroll
                    for (int j = 0; j < 8; ++j) f[j] = tl[t * (64 * 65) + (kg * 8 + j) * 65 + n];
                    u32x4 w; w.x = cvt_pk_bf16(f[0], f[1]); w.y = cvt_pk_bf16(f[2], f[3]); w.z = cvt_pk_bf16(f[4], f[5]); w.w = cvt_pk_bf16(f[6], f[7]);
                    *(u32x4*)(dstp[t] + (size_t)n * ldk[t] + kg * 8) = w;
                }
        }
    }
    constexpr int RP = 3;
    for (int row0 = blk * 8 + wid; row0 < T_ALL; row0 += G * 8 * RP) {
        f32x4 v[RP][4];
#pragma unroll
        for (int r = 0; r < RP; ++r) {
            const int row = row0 + r * G * 8;
            if (row < T_ALL) {
                const float* src = xrow_ptr(p, row);
#pragma unroll
                for (int i = 0; i < 4; ++i) v[r][i] = __builtin_nontemporal_load((const f32x4*)(src + i * 256 + lane * 4));
            }
        }
#pragma unroll
        for (int r = 0; r < RP; ++r) {
            const int row = row0 + r * G * 8;
            if (row < T_ALL) {
                float ss = 0.f;
#pragma unroll
                for (int i = 0; i < 4; ++i) ss += v[r][i][0] * v[r][i][0] + v[r][i][1] * v[r][i][1] + v[r][i][2] * v[r][i][2] + v[r][i][3] * v[r][i][3];
#pragma unroll
                for (int o = 32; o >= 1; o >>= 1) ss += __shfl_xor(ss, o);
                const float rs = rsqrtf(ss * (1.f / 1024.f) + EPS);
#pragma unroll
                for (int i = 0; i < 4; ++i) {
                    u32x2 w; w.x = cvt_pk_bf16(v[r][i][0] * rs, v[r][i][1] * rs); w.y = cvt_pk_bf16(v[r][i][2] * rs, v[r][i][3] * rs);
                    *(u32x2*)(p.xn + (size_t)row * DM + i * 256 + lane * 4) = w;
                }
            }
        }
    }
}

constexpr int XCD_BAR_WORDS_C = 3456;
constexpr int PCNT_OFF = 3800;
constexpr int BM = 256, BK = 64, HALF = 128, HTB = HALF * BK * 2, NXCD = 8, WGM = 8;
__device__ __forceinline__ int lds_byte(int r, int c) { const int st = (r >> 4) * 2 + (c >> 5), rr = r & 15, cc = c & 31, ob = rr * 64 + cc * 2; return st * 1024 + (ob ^ (((ob >> 9) & 1) << 5)); }
__device__ __forceinline__ void stage_rc(int b, int& R, int& C) { const int st = b / 1024, sb = b % 1024, swz = sb ^ (((sb >> 9) & 1) << 5); R = (st >> 1) * 16 + swz / 64; C = (st & 1) * 32 + (swz % 64) / 2; }
__device__ __forceinline__ int perm32(int rho) { const int n = rho >> 4, i = rho & 15; return 8 * (i >> 2) + 4 * n + (i & 3); }
struct Unit { int pm, pn; };

template <int MODE, bool SINGLE>
__device__ __forceinline__ bool unit_next(int i, int G, int c, Unit& u, int spm, int spn) {
    if (SINGLE) { u.pm = spm; u.pn = spn; return i == 0; }
    constexpr int nM = (MODE == 1) ? 136 : 128, nN = (MODE == 1) ? 22 : 4, nwg = nM * nN;
    const long L = (long)i * G + c; if (L >= nwg) return false;
    int wgid = (int)L; { const int q = nwg / NXCD, r = nwg % NXCD, xcd = wgid % NXCD, off = wgid / NXCD; wgid = (xcd < r ? xcd * (q + 1) : r * (q + 1) + (xcd - r) * q) + off; }
    const int nig = WGM * nN, gid = wgid / nig, fm = gid * WGM, gsz = (nM - fm) < WGM ? (nM - fm) : WGM;
    u.pm = fm + ((wgid % nig) % gsz); u.pn = (wgid % nig) / gsz; return true;
}

template <int MODE, bool SINGLE = false, bool FUSE = false>
__device__ __forceinline__ void gemm_phase(const Params& p, LAS unsigned char* lds, int spm = 0, int spn = 0, int cblk_override = -1) {
    constexpr int K = (MODE == 1) ? 1024 : 2048;
    constexpr int LDA = (MODE == 1) ? 1024 : HS;
    constexpr bool PERM = (MODE == 1);
    constexpr int nt = K / BK;
    const int tid = threadIdx.x, wid = __builtin_amdgcn_readfirstlane(tid >> 6), lane = tid & 63, wr = wid >> 2, wc = wid & 3, fr = lane & 15, fq = lane >> 4;
    const int G = gridDim.x, cblk = cblk_override >= 0 ? cblk_override : (int)blockIdx.x;
    const char* Abase = (MODE == 1) ? (const char*)p.xn : (const char*)(p.h + 3072);
    const char* Bbase = (MODE == 1) ? (const char*)p.WinT : (const char*)p.WoutT;
    unsigned voffA[2], voffB[2];
#pragma unroll
    for (int i = 0; i < 2; ++i) { int R, C; stage_rc(tid * 16 + i * 8192, R, C); const int Rb = PERM ? ((R & ~31) + perm32(R & 31)) : R;
        voffA[i] = (unsigned)(R * LDA + C) * 2u; voffB[i] = (unsigned)(Rb * K + C) * 2u; }
    constexpr size_t kstep = (size_t)(BK * 2);
    constexpr size_t hstepA = (size_t)HALF * LDA * 2, tstepA = 2 * hstepA;
    constexpr size_t hstepB = (size_t)HALF * K * 2, tstepB = 2 * hstepB;
    const unsigned ldsw = (unsigned)wid * 1024u;
    const int aoff = lds_byte(wr * 64 + fr, fq * 8), boff = lds_byte(wc * 32 + fr, fq * 8);
#define AK(t) ((long)(t) * 128 + ((MODE == 2 && (t) >= 16) ? -8192L : 0L))
#define PG8_SA(b, h) (((b) * 2 + (h)) * HTB)
#define PG8_SB(b, h) ((4 + (b) * 2 + (h)) * HTB)
#define PG8_STAGE(bufoff, gbase, voff) do { _Pragma("unroll") for (int _i = 0; _i < 2; ++_i) \
        __builtin_amdgcn_global_load_lds((const unsigned*)((const char*)(gbase) + (voff)[_i]), (LAS unsigned*)(lds + (bufoff) + ldsw + _i * 8192), 16, 0, 0); } while (0)
#define PG8_LDA(dst, b, h) do { _Pragma("unroll") for (int m = 0; m < 4; ++m) _Pragma("unroll") for (int k = 0; k < 2; ++k) dst[m][k] = *(const LAS bf16x8*)(lds + PG8_SA(b, h) + aoff + m * 2048 + k * 1024); } while (0)
#define PG8_LDB(dst, b, h) do { _Pragma("unroll") for (int n = 0; n < 2; ++n) _Pragma("unroll") for (int k = 0; k < 2; ++k) dst[n][k] = *(const LAS bf16x8*)(lds + PG8_SB(b, h) + boff + n * 2048 + k * 1024); } while (0)
#define PG8_MMA(ai, bj, At, Bt) do { __builtin_amdgcn_s_setprio(1); _Pragma("unroll") for (int m = 0; m < 4; ++m) _Pragma("unroll") for (int n = 0; n < 2; ++n) _Pragma("unroll") for (int k = 0; k < 2; ++k) \
        acc[ai][bj][m][n] = __builtin_amdgcn_mfma_f32_16x16x32_bf16(Bt[n][k], At[m][k], acc[ai][bj][m][n], 0, 0, 0); __builtin_amdgcn_s_setprio(0); } while (0)
#define PG8_WAIT_V(n) asm volatile("s_waitcnt vmcnt(" #n ")" ::: "memory")
#define PG8_WAIT_L(n) asm volatile("s_waitcnt lgkmcnt(" #n ")" ::: "memory")
#define PG8_BAR __builtin_amdgcn_s_barrier()
#define PG8_SCHED __builtin_amdgcn_sched_barrier(0)
    Unit cur, nxt; int ui = 0;
    if (!unit_next<MODE, SINGLE>(0, G, cblk, cur, spm, spn)) return;
    f32x4 acc[2][2][4][2];
#pragma unroll
    for (int a = 0; a < 2; ++a)
#pragma unroll
        for (int b = 0; b < 2; ++b)
#pragma unroll
            for (int m = 0; m < 4; ++m)
#pragma unroll
                for (int n = 0; n < 2; ++n) acc[a][b][m][n] = (f32x4){0.f, 0.f, 0.f, 0.f};
    bf16x8 At[4][2], B0[2][2], B1[2][2];
    const char* cA = Abase + (size_t)cur.pm * tstepA; const char* cB = Bbase + (size_t)cur.pn * tstepB;
    PG8_STAGE(PG8_SB(0, 0), cB, voffB); PG8_STAGE(PG8_SA(0, 0), cA, voffA); PG8_STAGE(PG8_SB(0, 1), cB + hstepB, voffB); PG8_STAGE(PG8_SA(0, 1), cA + hstepA, voffA);
    if (wr == 1) PG8_BAR;
    PG8_WAIT_V(4); PG8_BAR;
    PG8_STAGE(PG8_SB(1, 0), cB + kstep, voffB); PG8_STAGE(PG8_SA(1, 0), cA + kstep, voffA); PG8_STAGE(PG8_SB(1, 1), cB + hstepB + kstep, voffB);
    PG8_WAIT_V(6); PG8_BAR;
    for (;;) {
        const bool has_next = unit_next<MODE, SINGLE>(ui + 1, G, cblk, nxt, spm, spn);
        const char* nA = has_next ? Abase + (size_t)nxt.pm * tstepA : cA; const char* nB = has_next ? Bbase + (size_t)nxt.pn * tstepB : cB;
#if DIAG == 3
        const unsigned long long tk0 = __builtin_amdgcn_s_memrealtime();
#endif
#pragma unroll 1
        for (int t = 0; t < nt; t += 2) {
            const bool last = (t == nt - 2);
            const char* a1 = cA + AK(t + 1);
            const char* a2 = last ? nA : cA + AK(t + 2); const char* b2 = last ? nB : cB + (size_t)(t + 2) * kstep;
            const char* a3 = last ? nA + kstep : cA + AK(t + 3); const char* b3 = b2 + kstep;
            if (MODE == 2 && t == 16) {
#pragma unroll
                for (int ai = 0; ai < 2; ++ai)
#pragma unroll
                    for (int m = 0; m < 4; ++m) {
                        const int row = cur.pm * BM + ai * HALF + wr * 64 + m * 16 + fr;
                        const float r = rsqrtf(p.ssq[row] * (1.f / 1024.f) + EPS);
#pragma unroll
                        for (int bj = 0; bj < 2; ++bj)
#pragma unroll
                            for (int n = 0; n < 2; ++n) acc[ai][bj][m][n] *= r;
                    }
            }
            PG8_LDB(B0, 0, 0); PG8_SCHED; PG8_LDA(At, 0, 0); PG8_STAGE(PG8_SA(1, 1), a1 + hstepA, voffA);
            PG8_WAIT_L(8); PG8_BAR; PG8_WAIT_L(0); PG8_MMA(0, 0, At, B0); PG8_BAR; PG8_SCHED;
            PG8_LDB(B1, 0, 1); PG8_STAGE(PG8_SB(0, 0), b2, voffB);
            PG8_BAR; PG8_WAIT_L(0); PG8_MMA(0, 1, At, B1); PG8_BAR;
            PG8_LDA(At, 0, 1); PG8_STAGE(PG8_SA(0, 0), a2, voffA);
            PG8_BAR; PG8_WAIT_L(0); PG8_MMA(1, 0, At, B0); PG8_BAR; PG8_SCHED;
            PG8_STAGE(PG8_SB(0, 1), b2 + hstepB, voffB);
            PG8_WAIT_V(6); PG8_BAR; PG8_MMA(1, 1, At, B1); PG8_BAR;
            PG8_LDB(B0, 1, 0); PG8_SCHED; PG8_LDA(At, 1, 0); PG8_STAGE(PG8_SA(0, 1), a2 + hstepA, voffA);
            PG8_WAIT_L(8); PG8_BAR; PG8_WAIT_L(0); PG8_MMA(0, 0, At, B0); PG8_BAR; PG8_SCHED;
            PG8_LDB(B1, 1, 1); PG8_STAGE(PG8_SB(1, 0), b3, voffB);
            PG8_BAR; PG8_WAIT_L(0); PG8_MMA(0, 1, At, B1); PG8_BAR;
            PG8_LDA(At, 1, 1); PG8_STAGE(PG8_SA(1, 0), a3, voffA);
            PG8_BAR; PG8_WAIT_L(0); PG8_MMA(1, 0, At, B0); PG8_BAR; PG8_SCHED;
            PG8_STAGE(PG8_SB(1, 1), b3 + hstepB, voffB);
            PG8_WAIT_V(6); PG8_BAR; PG8_MMA(1, 1, At, B1); PG8_BAR;
        }
#if DIAG == 3
        const unsigned long long tk1 = __builtin_amdgcn_s_memrealtime();
#endif
        if (MODE == 1) {
            const int row0 = cur.pm * BM + wr * 64 + fr, col0 = cur.pn * BM + wc * 32 + 8 * fq;
            const bool isV = (cur.pn >= 4 && cur.pn < 8);
#pragma unroll
            for (int ai = 0; ai < 2; ++ai)
#pragma unroll
                for (int m = 0; m < 4; ++m) {
                    const int row = row0 + ai * HALF + m * 16;
                    bf16_t* rowp = p.h + (size_t)row * HS + col0;
                    float s = 0.f, ss = 0.f;
#pragma unroll
                    for (int bj = 0; bj < 2; ++bj) {
                        const f32x4 v0 = acc[ai][bj][m][0], v1 = acc[ai][bj][m][1];
                        u32x4 w; w.x = cvt_pk_bf16(v0[0], v0[1]); w.y = cvt_pk_bf16(v0[2], v0[3]); w.z = cvt_pk_bf16(v1[0], v1[1]); w.w = cvt_pk_bf16(v1[2], v1[3]);
                        __builtin_nontemporal_store(w, (u32x4*)(rowp + bj * HALF));
                        s += (v0[0] + v0[1]) + (v0[2] + v0[3]) + (v1[0] + v1[1]) + (v1[2] + v1[3]);
                        ss += v0[0] * v0[0] + v0[1] * v0[1] + v0[2] * v0[2] + v0[3] * v0[3] + v1[0] * v1[0] + v1[1] * v1[1] + v1[2] * v1[2] + v1[3] * v1[3];
                    }
                    if (isV) {
                        s += __shfl_xor(s, 16); ss += __shfl_xor(ss, 16);
                        s += __shfl_xor(s, 32); ss += __shfl_xor(ss, 32);
                        if (fq == 0) { f32x2 o; o.x = s; o.y = ss; *(f32x2*)(p.stats + ((size_t)row * 16 + (cur.pn - 4) * 4 + wc) * 2) = o; }
                    }
                }
        } else if (!FUSE) {
            const int row0 = cur.pm * BM + wr * 64 + fr, col0 = cur.pn * BM + wc * 32 + 4 * fq;
#pragma unroll
            for (int ai = 0; ai < 2; ++ai)
#pragma unroll
                for (int m = 0; m < 4; ++m) {
                    const int row = row0 + ai * HALF + m * 16;
                    const float* xr = xrow_ptr(p, row) + col0;
                    float* orow = p.out + (size_t)row * DM + col0;
                    float ss = 0.f;
#pragma unroll
                    for (int bj = 0; bj < 2; ++bj)
#pragma unroll
                        for (int n = 0; n < 2; ++n) {
                            const f32x4 xv = __builtin_nontemporal_load((const f32x4*)(xr + bj * HALF + n * 16));
                            const f32x4 v = acc[ai][bj][m][n] + xv;
                            *(f32x4*)(orow + bj * HALF + n * 16) = v;
                            ss += v[0] * v[0] + v[1] * v[1] + v[2] * v[2] + v[3] * v[3];
                        }
                    ss += __shfl_xor(ss, 16); ss += __shfl_xor(ss, 32);
                    if (fq == 0) p.fpart[(size_t)row * 16 + cur.pn * 4 + wc] = ss;
                }
        } else {
            PG8_SCHED; if (wr == 0) PG8_BAR; PG8_SCHED;
            const int row0 = cur.pm * BM + wr * 64 + fr, col0 = cur.pn * BM + wc * 32 + 4 * fq;
#pragma unroll
            for (int ai = 0; ai < 2; ++ai)
#pragma unroll
                for (int m = 0; m < 4; ++m) {
                    const int row = row0 + ai * HALF + m * 16;
                    const float* xr = xrow_ptr(p, row) + col0;
                    float ss = 0.f;
#pragma unroll
                    for (int bj = 0; bj < 2; ++bj)
#pragma unroll
                        for (int n = 0; n < 2; ++n) {
                            const f32x4 xv = __builtin_nontemporal_load((const f32x4*)(xr + bj * HALF + n * 16));
                            const f32x4 v = acc[ai][bj][m][n] + xv;
                            acc[ai][bj][m][n] = v;
                            ss += v[0] * v[0] + v[1] * v[1] + v[2] * v[2] + v[3] * v[3];
                        }
                    ss += __shfl_xor(ss, 16); ss += __shfl_xor(ss, 32);
                    if (fq == 0) __hip_atomic_store(p.fpart + (size_t)row * 16 + cur.pn * 4 + wc, ss, __ATOMIC_RELAXED, __HIP_MEMORY_SCOPE_AGENT);
                }
            asm volatile("s_waitcnt vmcnt(0)" ::: "memory");
            unsigned* pc = p.bar + XCD_BAR_WORDS_C + cur.pm * 2 + wr;
            if (lane == 0) __hip_atomic_fetch_add(pc, 1u, __ATOMIC_RELAXED, __HIP_MEMORY_SCOPE_AGENT);
            { unsigned sp = 0; while (__hip_atomic_load(pc, __ATOMIC_RELAXED, __HIP_MEMORY_SCOPE_AGENT) < 16u) { __builtin_amdgcn_s_sleep(2); if (++sp > (1u << 20)) break; } }
            asm volatile("" ::: "memory");
            f32x4 nw[2][2];
#pragma unroll
            for (int bj = 0; bj < 2; ++bj)
#pragma unroll
                for (int n = 0; n < 2; ++n) nw[bj][n] = *(const f32x4*)(p.norm_f_w + col0 + bj * HALF + n * 16);
#pragma unroll
            for (int ai = 0; ai < 2; ++ai)
#pragma unroll
                for (int m = 0; m < 4; ++m) {
                    const int row = row0 + ai * HALF + m * 16;
                    unsigned long long* fp = (unsigned long long*)(p.fpart + (size_t)row * 16 + fq * 4);
                    const unsigned long long a = __hip_atomic_load(fp, __ATOMIC_RELAXED, __HIP_MEMORY_SCOPE_AGENT), b = __hip_atomic_load(fp + 1, __ATOMIC_RELAXED, __HIP_MEMORY_SCOPE_AGENT);
                    float s = (__uint_as_float((unsigned)a) + __uint_as_float((unsigned)(a >> 32))) + (__uint_as_float((unsigned)b) + __uint_as_float((unsigned)(b >> 32)));
                    s += __shfl_xor(s, 16); s += __shfl_xor(s, 32);
                    const float rs = rsqrtf(s * (1.f / 1024.f) + EPS);
                    float* orow = p.out + (size_t)row * DM + col0;
#pragma unroll
                    for (int bj = 0; bj < 2; ++bj)
#pragma unroll
                        for (int n = 0; n < 2; ++n) __builtin_nontemporal_store(acc[ai][bj][m][n] * rs * nw[bj][n], (f32x4*)(orow + bj * HALF + n * 16));
                }
            PG8_SCHED; if (wr == 1) PG8_BAR; PG8_SCHED;
        }
#if DIAG == 3
        if (MODE == DIAG_A && !SINGLE && blockIdx.x == 0 && tid == 0) { const unsigned long long tk2 = __builtin_amdgcn_s_memrealtime(); atomicAdd(p.ctr + 40, (unsigned)(tk1 - tk0)); atomicAdd(p.ctr + 41, (unsigned)(tk2 - tk1)); }
#endif
        if (!has_next) break;
#pragma unroll
        for (int a = 0; a < 2; ++a)
#pragma unroll
            for (int b = 0; b < 2; ++b)
#pragma unroll
                for (int m = 0; m < 4; ++m)
#pragma unroll
                    for (int n = 0; n < 2; ++n) acc[a][b][m][n] = (f32x4){0.f, 0.f, 0.f, 0.f};
        cur = nxt; cA = nA; cB = nB; ++ui;
    }
    PG8_WAIT_V(0);
    if (wr == 0) PG8_BAR;
    PG8_BAR;
#undef AK
#undef PG8_SA
#undef PG8_SB
#undef PG8_STAGE
#undef PG8_LDA
#undef PG8_LDB
#undef PG8_MMA
#undef PG8_WAIT_V
#undef PG8_WAIT_L
#undef PG8_BAR
#undef PG8_SCHED
}

__device__ __forceinline__ void dt_panel(const Params& p, LAS unsigned char* lds, int pm) {
    const int tid = threadIdx.x, lane = tid & 63, wid = tid >> 6, fr = lane & 15, fq = lane >> 4;
    constexpr int D_WS = 69632;
    __syncthreads();
    for (int i = tid; i < 16 * 128; i += 512) {
        const int r = i >> 7, cq = i & 127;
        *(LAS bf16x8*)(lds + D_WS + (r * 1032 + cq * 8) * 2) = *(const bf16x8*)(p.WdtT + (size_t)r * 1024 + cq * 8);
    }
    const int rr = tid >> 4, cc = (tid & 15) * 8;
    const bf16_t* ag = p.xn + (size_t)(pm * 256 + rr) * DM + cc;
    bf16x8 q[8];
#pragma unroll
    for (int i = 0; i < 8; ++i) q[i] = *(const bf16x8*)(ag + (size_t)(32 * i) * DM);
    f32x4 d0 = (f32x4){0.f, 0.f, 0.f, 0.f}, d1 = (f32x4){0.f, 0.f, 0.f, 0.f};
#pragma unroll 1
    for (int kc = 0; kc < 8; ++kc) {
        __syncthreads();
#pragma unroll
        for (int i = 0; i < 8; ++i) *(LAS bf16x8*)(lds + ((rr + 32 * i) * 136 + cc) * 2) = q[i];
        if (kc + 1 < 8) {
#pragma unroll
            for (int i = 0; i < 8; ++i) q[i] = *(const bf16x8*)(ag + (size_t)(32 * i) * DM + (kc + 1) * 128);
        }
        __syncthreads();
#pragma unroll
        for (int kk = 0; kk < 4; ++kk) {
            const bf16x8 b = *(const LAS bf16x8*)(lds + D_WS + (fr * 1032 + kc * 128 + kk * 32 + fq * 8) * 2);
            const bf16x8 a0 = *(const LAS bf16x8*)(lds + ((wid * 32 + fr) * 136 + kk * 32 + fq * 8) * 2);
            const bf16x8 a1 = *(const LAS bf16x8*)(lds + ((wid * 32 + 16 + fr) * 136 + kk * 32 + fq * 8) * 2);
            d0 = MFMA16(a0, b, d0);
            d1 = MFMA16(a1, b, d1);
        }
    }
    const int rb = pm * 256 + wid * 32;
#pragma unroll
    for (int j = 0; j < 4; ++j) {
        p.dtraw[(size_t)(rb + fq * 4 + j) * 16 + fr] = d0[j];
        p.dtraw[(size_t)(rb + 16 + fq * 4 + j) * 16 + fr] = d1[j];
    }
}
__device__ __forceinline__ void phase1_tail(const Params& p, LAS unsigned char* lds, int c) {
    const int G = gridDim.x, rem = 2992 % G;
    const int first = rem ? rem : 0, nidle = G - first;
    if (c >= first) for (int pm = c - first; pm < 136; pm += nidle) dt_panel(p, lds, pm);
}

__device__ __forceinline__ void unpack8(const bf16x8 v, float* f) {
    const u32x4 w = __builtin_bit_cast(u32x4, v);
    f[0] = bf_lo(w.x); f[1] = bf_hi(w.x); f[2] = bf_lo(w.y); f[3] = bf_hi(w.y); f[4] = bf_lo(w.z); f[5] = bf_hi(w.z); f[6] = bf_lo(w.w); f[7] = bf_hi(w.w);
}

struct ConvRaw { bf16x8 r[11]; };
constexpr int L_CW = 4096;

__device__ __forceinline__ void conv_load(const Params& p, int ci, int third, ConvRaw& R) {
    const int u = third * 512 + (int)threadIdx.x, cg_ = u % 192, rb = u / 192, ch0 = cg_ * 8;
    const bool halo = rb > 0 || (ci < 512 && (ci & 63) != 0);
    const bf16_t* hx = p.h + (size_t)(ci * 64 + rb * 8) * HS + 4096 + ch0;
    if (halo) {
#pragma unroll
        for (int k = 0; k < 3; ++k) R.r[k] = *(const bf16x8*)(hx + (long)(k - 3) * HS);
    }
#pragma unroll
    for (int k = 3; k < 11; ++k) R.r[k] = __builtin_nontemporal_load((const bf16x8*)(hx + (long)(k - 3) * HS));
}

__device__ __forceinline__ void conv_compute(const Params& p, LAS unsigned char* lds, int ci, int third, const ConvRaw& R) {
    const int tid = threadIdx.x;
    const int u = third * 512 + tid, cg_ = u % 192, rb = u / 192, ch0 = cg_ * 8;
    const int r0 = ci * 64;
    const bool prompt = ci < 512;
    const int c = ci & 63;
    float w0[8], w1[8], w2[8], w3[8], bb[8];
    {
        const LAS float* cw = (const LAS float*)(lds + L_CW) + ch0;
#pragma unroll
        for (int q = 0; q < 2; ++q) {
            const f32x4 a0 = *(const LAS f32x4*)(cw + 0 * XS + q * 4), a1 = *(const LAS f32x4*)(cw + 1 * XS + q * 4);
            const f32x4 a2 = *(const LAS f32x4*)(cw + 2 * XS + q * 4), a3 = *(const LAS f32x4*)(cw + 3 * XS + q * 4);
            const f32x4 b4 = *(const LAS f32x4*)(cw + 4 * XS + q * 4);
#pragma unroll
            for (int j = 0; j < 4; ++j) { w0[q * 4 + j] = a0[j]; w1[q * 4 + j] = a1[j]; w2[q * 4 + j] = a2[j]; w3[q * 4 + j] = a3[j]; bb[q * 4 + j] = b4[j]; }
        }
    }
    float x0[8], x1[8], x2[8];
    if (rb > 0 || (prompt && c != 0)) {
        unpack8(R.r[0], x0); unpack8(R.r[1], x1); unpack8(R.r[2], x2);
    } else if (prompt) {
#pragma unroll
        for (int j = 0; j < 8; ++j) { x0[j] = 0.f; x1[j] = 0.f; x2[j] = 0.f; }
    } else {
        const float* sc = p.state_conv + (size_t)(ci - 512) * 3 * XS + ch0;
#pragma unroll
        for (int q = 0; q < 2; ++q) {
            const f32x4 a0 = *(const f32x4*)(sc + 0 * XS + q * 4), a1 = *(const f32x4*)(sc + 1 * XS + q * 4), a2 = *(const f32x4*)(sc + 2 * XS + q * 4);
#pragma unroll
            for (int j = 0; j < 4; ++j) { x0[q * 4 + j] = a0[j]; x1[q * 4 + j] = a1[j]; x2[q * 4 + j] = a2[j]; }
        }
    }
    unsigned ob[8][4];
#pragma unroll
    for (int rr = 0; rr < 8; ++rr) {
        float cur[8], o[8];
        unpack8(R.r[3 + rr], cur);
#pragma unroll
        for (int j = 0; j < 8; ++j) {
            const float y = bb[j] + w0[j] * x0[j] + w1[j] * x1[j] + w2[j] * x2[j] + w3[j] * cur[j];
            o[j] = silu_f(y);
            x0[j] = x1[j]; x1[j] = x2[j]; x2[j] = cur[j];
        }
        u32x4 w; w.x = cvt_pk_bf16(o[0], o[1]); w.y = cvt_pk_bf16(o[2], o[3]); w.z = cvt_pk_bf16(o[4], o[5]); w.w = cvt_pk_bf16(o[6], o[7]);
        *(u32x4*)(p.xbc + (size_t)(r0 + rb * 8 + rr) * XSB + ch0) = w;
        ob[rr][0] = w.x; ob[rr][1] = w.y; ob[rr][2] = w.z; ob[rr][3] = w.w;
    }
    if (ch0 >= 1024 && ch0 < 1280) {
        const int g = (ch0 - 1024) >> 7, n0 = (ch0 - 1024) & 127;
        bf16_t* bt = p.BT + ((size_t)(ci * 2 + g) * 128 + n0) * 64 + rb * 8;
#pragma unroll
        for (int j = 0; j < 8; ++j) {
            unsigned e[8];
#pragma unroll
            for (int rr = 0; rr < 8; ++rr) e[rr] = (j & 1) ? (ob[rr][j >> 1] >> 16) : (ob[rr][j >> 1] & 0xffffu);
            u32x4 w; w.x = e[0] | (e[1] << 16); w.y = e[2] | (e[3] << 16); w.z = e[4] | (e[5] << 16); w.w = e[6] | (e[7] << 16);
            *(u32x4*)(bt + (size_t)j * 64) = w;
        }
    }
    if (rb == 7 && (!prompt || c == 63)) {
        float* dst = prompt ? p.out + O_CONVP + (size_t)(ci >> 6) * 3 * XS + ch0 : p.out + O_CONVS + (size_t)(ci - 512) * 3 * XS + ch0;
#pragma unroll
        for (int q = 0; q < 2; ++q) {
            *(f32x4*)(dst + 0 * XS + q * 4) = (f32x4){x0[q * 4], x0[q * 4 + 1], x0[q * 4 + 2], x0[q * 4 + 3]};
            *(f32x4*)(dst + 1 * XS + q * 4) = (f32x4){x1[q * 4], x1[q * 4 + 1], x1[q * 4 + 2], x1[q * 4 + 3]};
            *(f32x4*)(dst + 2 * XS + q * 4) = (f32x4){x2[q * 4], x2[q * 4 + 1], x2[q * 4 + 2], x2[q * 4 + 3]};
        }
    }
}

__device__ __forceinline__ void dt_item(const Params& p, LAS unsigned char* lds, int ci) {
    const int tid = threadIdx.x, lane = tid & 63, wid = tid >> 6, fr = lane & 15, fq = lane >> 4;
    const int r0 = ci * 64;
    LAS float* sDt = (LAS float*)lds;
    __syncthreads();
#pragma unroll
    for (int i = 0; i < 2; ++i) {
        const int idx = tid + 512 * i, l = idx >> 4, hd = idx & 15;
        const float xx = p.dtraw[(size_t)(r0 + l) * 16 + hd] + p.dt_bias[hd];
        sDt[hd * 64 + l] = xx > 20.f ? xx : log1pf(__expf(xx));
    }
    __syncthreads();
#pragma unroll
    for (int hh = 0; hh < 2; ++hh) {
        const int hd = wid + hh * 8;
        const float dtv = sDt[hd * 64 + lane];
        const float a = -__expf(p.a_log[hd]);
        float v = dtv * a;
#pragma unroll
        for (int o = 1; o < 64; o <<= 1) { const float t = __shfl_up(v, o); if (lane >= o) v += t; }
        p.dtT[((size_t)ci * 16 + hd) * 64 + lane] = dtv;
        p.acT[((size_t)ci * 16 + hd) * 64 + lane] = v;
    }
}

__device__ __forceinline__ void phase2a(const Params& p, LAS unsigned char* lds) {
    const int G = gridDim.x, blk = blockIdx.x;
    for (int i = threadIdx.x; i < 5 * XS; i += 512) ((LAS float*)(lds + L_CW))[i] = i < 4 * XS ? p.conv_w[i] : p.conv_b[i - 4 * XS];
    __syncthreads();
    ConvRaw A, B;
    if (blk < 1632) conv_load(p, blk / 3, blk % 3, A);
#pragma unroll 1
    for (int it = blk; it < 1632; it += 2 * G) {
        const int it1 = it + G, it2 = it + 2 * G;
        if (it1 < 1632) conv_load(p, it1 / 3, it1 % 3, B);
        conv_compute(p, lds, it / 3, it % 3, A);
        if (it2 < 1632) conv_load(p, it2 / 3, it2 % 3, A);
        if (it1 < 1632) conv_compute(p, lds, it1 / 3, it1 % 3, B);
    }
    for (int it = G - 1 - blk; it < 544; it += G) dt_item(p, lds, it);
}

#define LDS_BARRIER() do { asm volatile("s_waitcnt lgkmcnt(0)" ::: "memory"); __builtin_amdgcn_s_barrier(); asm volatile("" ::: "memory"); } while (0)
__device__ __forceinline__ void item_done(const Params& p) {
    asm volatile("s_waitcnt vmcnt(0)" ::: "memory");
    __syncthreads();
    if (threadIdx.x == 0) __hip_atomic_fetch_add(p.ctr + 1, 1u, __ATOMIC_RELAXED, __HIP_MEMORY_SCOPE_AGENT);
}
struct SsdStage { bf16x8 B[2], C[2], BT[2], z, xc; float dt, ac; };
constexpr int L_BS = 0, L_CS = 17408, L_BTS = 34816, L_ZS = 53248, L_XL = 62464, L_XT = 71680, L_XDD = 80896, L_MX = 90112, L_HL = 99328, L_DTS = 116736, L_ACS = 116992;

__device__ __forceinline__ void ssd_stage_load(const Params& p, int r0, int hd, int g, int tid, SsdStage& s) {
    const int lane = tid & 63, wid = tid >> 6, ci = r0 >> 6;
    const bf16_t* xb = p.xbc + (size_t)r0 * XSB;
    const int rr = tid >> 4, cc = (tid & 15) * 8;
    s.B[0] = __builtin_nontemporal_load((const bf16x8*)(xb + (size_t)rr * XSB + 1024 + g * 128 + cc));
    s.B[1] = __builtin_nontemporal_load((const bf16x8*)(xb + (size_t)(rr + 32) * XSB + 1024 + g * 128 + cc));
    s.C[0] = __builtin_nontemporal_load((const bf16x8*)(xb + (size_t)rr * XSB + 1280 + g * 128 + cc));
    s.C[1] = __builtin_nontemporal_load((const bf16x8*)(xb + (size_t)(rr + 32) * XSB + 1280 + g * 128 + cc));
    const bf16_t* bt = p.BT + (size_t)(ci * 2 + g) * 8192;
    s.BT[0] = __builtin_nontemporal_load((const bf16x8*)(bt + tid * 8));
    s.BT[1] = __builtin_nontemporal_load((const bf16x8*)(bt + 4096 + tid * 8));
    s.z = __builtin_nontemporal_load((const bf16x8*)(p.h + (size_t)(r0 + (tid >> 3)) * HS + 3072 + hd * 64 + (tid & 7) * 8));
    s.xc = *(const bf16x8*)(xb + (size_t)lane * XSB + hd * 64 + wid * 8);
    s.dt = p.dtT[((size_t)ci * 16 + hd) * 64 + lane];
    s.ac = p.acT[((size_t)ci * 16 + hd) * 64 + lane];
}

__device__ __forceinline__ void ssd_item(const Params& p, LAS unsigned char* lds, int seq, int hd) {
    const int tid = threadIdx.x, lane = tid & 63, wid = __builtin_amdgcn_readfirstlane(tid >> 6), fr = lane & 15, fq = lane >> 4, lt = wid >> 1;
    const bool prompt = seq < 8;
    const int nch = prompt ? 64 : 1;
    const int rbase = prompt ? seq * 4096 : T_PROMPT + (seq - 8) * 64;
    const int g = hd >> 3;
    const float Dsk = p.d_skip[hd];
    f32x4 hT[4];
    float* hout = prompt ? p.out + O_SSMP + (size_t)(seq * 16 + hd) * 8192 : p.out + O_SSMS + (size_t)((seq - 8) * 16 + hd) * 8192;
    if (prompt) {
#pragma unroll
        for (int pt = 0; pt < 4; ++pt) hT[pt] = (f32x4){0.f, 0.f, 0.f, 0.f};
    } else {
        const float* h0 = p.state_ssm + (size_t)((seq - 8) * 16 + hd) * 8192;
#pragma unroll
        for (int pt = 0; pt < 4; ++pt) hT[pt] = *(const f32x4*)(h0 + (size_t)(pt * 16 + fr) * 128 + wid * 16 + fq * 4);
    }
    LAS bf16_t* xT = (LAS bf16_t*)(lds + L_XT); LAS bf16_t* xdd = (LAS bf16_t*)(lds + L_XDD);
    LAS float* dts = (LAS float*)(lds + L_DTS); LAS float* acs = (LAS float*)(lds + L_ACS);
    SsdStage sA, sB;
    ssd_stage_load(p, rbase, hd, g, tid, sA);
    ssd_stage_load(p, nch > 1 ? rbase + 64 : rbase, hd, g, tid, sB);
    auto chunk_body = [&](const int c, SsdStage& s0) __attribute__((always_inline)) {
        const int r0 = rbase + c * 64;
        {
            const int rr = tid >> 4, cc = (tid & 15) * 8;
            *(LAS bf16x8*)(lds + L_BS + (rr * 136 + cc) * 2) = s0.B[0];
            *(LAS bf16x8*)(lds + L_BS + ((rr + 32) * 136 + cc) * 2) = s0.B[1];
            *(LAS bf16x8*)(lds + L_CS + (rr * 136 + cc) * 2) = s0.C[0];
            *(LAS bf16x8*)(lds + L_CS + ((rr + 32) * 136 + cc) * 2) = s0.C[1];
            *(LAS bf16x8*)(lds + L_BTS + ((tid >> 3) * 72 + (tid & 7) * 8) * 2) = s0.BT[0];
            *(LAS bf16x8*)(lds + L_BTS + (((tid >> 3) + 64) * 72 + (tid & 7) * 8) * 2) = s0.BT[1];
            *(LAS bf16x8*)(lds + L_ZS + ((tid >> 3) * 72 + (tid & 7) * 8) * 2) = s0.z;
            *(LAS bf16x8*)(lds + L_XL + (lane * 72 + wid * 8) * 2) = s0.xc;
            if (wid == 0) { dts[lane] = s0.dt; acs[lane] = s0.ac; }
            const float ac63 = __shfl(s0.ac, 63);
            const float decl = __expf(ac63 - s0.ac) * s0.dt;
            float xf[8]; unpack8(s0.xc, xf);
#pragma unroll
            for (int j = 0; j < 8; ++j) {
                xT[(wid * 8 + j) * 72 + lane] = (bf16_t)s0.xc[j];
                xdd[(wid * 8 + j) * 72 + lane] = (bf16_t)(cvt_pk_bf16(xf[j] * decl, 0.f) & 0xffffu);
            }
#pragma unroll
            for (int pt = 0; pt < 4; ++pt) {
                u32x2 w; w.x = cvt_pk_bf16(hT[pt][0], hT[pt][1]); w.y = cvt_pk_bf16(hT[pt][2], hT[pt][3]);
                *(LAS u32x2*)(lds + L_HL + ((pt * 16 + fr) * 136 + wid * 16 + fq * 4) * 2) = w;
            }
        }
        const bool sig = prompt && c >= 4 && (c & 3) == 0;
        if (sig) asm volatile("s_waitcnt vmcnt(0)" ::: "memory");
        if (c + 2 < nch) ssd_stage_load(p, r0 + 128, hd, g, tid, s0);
        LDS_BARRIER();
        if (sig && tid == 0) __hip_atomic_fetch_add(p.bar + PCNT_OFF + seq * 16 + (c >> 2) - 1, 1u, __ATOMIC_RELAXED, __HIP_MEMORY_SCOPE_AGENT);
        bf16x8 Cf[4];
#pragma unroll
        for (int kk = 0; kk < 4; ++kk) Cf[kk] = *(const LAS bf16x8*)(lds + L_CS + ((lt * 16 + fr) * 136 + kk * 32 + fq * 8) * 2);
        const float ac_l = acs[lt * 16 + fr];
        const float ac63u = acs[63];
        {
            const int lidx = lt * 16 + fr;
#pragma unroll
            for (int i = 0; i < 2; ++i) {
                const int st = (wid & 1) * 2 + i;
                f32x4 cb = (f32x4){0.f, 0.f, 0.f, 0.f};
#pragma unroll
                for (int kk = 0; kk < 4; ++kk) {
                    const bf16x8 Bf = *(const LAS bf16x8*)(lds + L_BS + ((st * 16 + fr) * 136 + kk * 32 + fq * 8) * 2);
                    cb = MFMA16(Bf, Cf[kk], cb);
                }
                const f32x4 ac_s = *(const LAS f32x4*)(acs + st * 16 + fq * 4);
                const f32x4 dt_s = *(const LAS f32x4*)(dts + st * 16 + fq * 4);
                float m[4];
#pragma unroll
                for (int j = 0; j < 4; ++j) {
                    const int s = st * 16 + fq * 4 + j;
                    const float diff = fminf(ac_l - ac_s[j], 0.f);
                    m[j] = (s <= lidx) ? cb[j] * __expf(diff) * dt_s[j] : 0.f;
                }
                u32x2 w; w.x = cvt_pk_bf16(m[0], m[1]); w.y = cvt_pk_bf16(m[2], m[3]);
                *(LAS u32x2*)(lds + L_MX + (lidx * 72 + st * 16 + fq * 4) * 2) = w;
            }
        }
        LDS_BARRIER();
        {
            const float el = __expf(ac_l);
            float ss = 0.f;
#pragma unroll
            for (int i = 0; i < 2; ++i) {
                const int pt = (wid & 1) * 2 + i;
                f32x4 yd = (f32x4){0.f, 0.f, 0.f, 0.f}, yo = (f32x4){0.f, 0.f, 0.f, 0.f};
#pragma unroll
                for (int kk = 0; kk < 2; ++kk) {
                    const bf16x8 A = *(const LAS bf16x8*)(lds + L_XT + ((pt * 16 + fr) * 72 + kk * 32 + fq * 8) * 2);
                    const bf16x8 Bo = *(const LAS bf16x8*)(lds + L_MX + ((lt * 16 + fr) * 72 + kk * 32 + fq * 8) * 2);
                    yd = MFMA16(A, Bo, yd);
                }
#pragma unroll
                for (int kk = 0; kk < 4; ++kk) {
                    const bf16x8 A = *(const LAS bf16x8*)(lds + L_HL + ((pt * 16 + fr) * 136 + kk * 32 + fq * 8) * 2);
                    yo = MFMA16(A, Cf[kk], yo);
                }
                const u32x2 xs = *(const LAS u32x2*)(lds + L_XL + ((lt * 16 + fr) * 72 + pt * 16 + fq * 4) * 2);
                const u32x2 zz = *(const LAS u32x2*)(lds + L_ZS + ((lt * 16 + fr) * 72 + pt * 16 + fq * 4) * 2);
                const float xv[4] = {bf_lo(xs.x), bf_hi(xs.x), bf_lo(xs.y), bf_hi(xs.y)};
                const float zv[4] = {bf_lo(zz.x), bf_hi(zz.x), bf_lo(zz.y), bf_hi(zz.y)};
                float yz[4];
#pragma unroll
                for (int j = 0; j < 4; ++j) { const float y = yd[j] + el * yo[j] + Dsk * xv[j]; yz[j] = y * silu_f(zv[j]); ss += yz[j] * yz[j]; }
                u32x2 w; w.x = cvt_pk_bf16(yz[0], yz[1]); w.y = cvt_pk_bf16(yz[2], yz[3]);
                bf16_t* yzp = p.h + (size_t)(r0 + lt * 16 + fr) * HS + 3072 + hd * 64 + pt * 16 + fq * 4;
                __hip_atomic_store((unsigned long long*)yzp, ((unsigned long long)w.y << 32) | w.x, __ATOMIC_RELAXED, __HIP_MEMORY_SCOPE_AGENT);
            }
            ss += __shfl_xor(ss, 16); ss += __shfl_xor(ss, 32);
            if (fq == 0) atomicAdd(p.ssq + r0 + lt * 16 + fr, ss);
            const float cd = __expf(ac63u);
            bf16x8 BTf[2];
#pragma unroll
            for (int kk = 0; kk < 2; ++kk) BTf[kk] = *(const LAS bf16x8*)(lds + L_BTS + ((wid * 16 + fr) * 72 + kk * 32 + fq * 8) * 2);
#pragma unroll
            for (int pt = 0; pt < 4; ++pt) {
                f32x4 acc = hT[pt] * cd;
#pragma unroll
                for (int kk = 0; kk < 2; ++kk) {
                    const bf16x8 Bo = *(const LAS bf16x8*)(lds + L_XDD + ((pt * 16 + fr) * 72 + kk * 32 + fq * 8) * 2);
                    acc = MFMA16(BTf[kk], Bo, acc);
                }
                hT[pt] = acc;
            }
        }
        LDS_BARRIER();
    };
#pragma unroll 1
    for (int c = 0; c < nch; c += 2) {
        chunk_body(c, sA);
        if (c + 1 < nch) chunk_body(c + 1, sB);
    }
#pragma unroll
    for (int pt = 0; pt < 4; ++pt) *(f32x4*)(hout + (size_t)(pt * 16 + fr) * 128 + wid * 16 + fq * 4) = hT[pt];
    if (!prompt) item_done(p);
    else {
        asm volatile("s_waitcnt vmcnt(0)" ::: "memory");
        __syncthreads();
        if (tid == 0) __hip_atomic_fetch_add(p.bar + PCNT_OFF + seq * 16 + 15, 1u, __ATOMIC_RELAXED, __HIP_MEMORY_SCOPE_AGENT);
    }
}

constexpr int G_VS = 0, G_WS = 34816, G_VNT = 69632, G_MU = 104448, G_RS = 104960;
__device__ __forceinline__ void gmlp_item(const Params& p, LAS unsigned char* lds, int item) {
    const int tid = threadIdx.x, lane = tid & 63, wid = __builtin_amdgcn_readfirstlane(tid >> 6), fr = lane & 15, fq = lane >> 4;
    const bool sample = item >= 2048;
    const int hd = item & 7;
    const int r0 = sample ? T_PROMPT + ((item - 2048) >> 3) * 128 : (item >> 3) * 128;
    LAS bf16_t* vnT = (LAS bf16_t*)(lds + G_VNT);
    LAS float* mus = (LAS float*)(lds + G_MU); LAS float* rss = (LAS float*)(lds + G_RS);
    const int wt = sample ? (wid & 3) : wid;
    const int kk0 = sample ? ((wid >> 2) * 2) : 0;
    const int nkk = sample ? 2 : (wid < 4 ? 2 : 4);
    const int rr = tid >> 4, cc = (tid & 15) * 8;
    bf16_t* hb = p.h + (size_t)(r0 + rr) * HS + hd * 128 + cc;
    bf16x8 vv[4], uu[4], gg[4], ww[4];
#pragma unroll
    for (int i = 0; i < 4; ++i) {
        vv[i] = __builtin_nontemporal_load((const bf16x8*)(hb + (size_t)i * 32 * HS + 1024));
        uu[i] = __builtin_nontemporal_load((const bf16x8*)(hb + (size_t)i * 32 * HS));
        gg[i] = __builtin_nontemporal_load((const bf16x8*)(hb + (size_t)i * 32 * HS + 2048));
        ww[i] = *(const bf16x8*)(p.Wm + ((size_t)hd * 128 + rr + 32 * i) * 128 + cc);
    }
    const f32x4 sp0 = *(const f32x4*)(p.stats + (size_t)r0 * 32 + tid * 4), sp1 = *(const f32x4*)(p.stats + (size_t)r0 * 32 + 2048 + tid * 4);
#pragma unroll
    for (int i = 0; i < 4; ++i) {
        *(LAS bf16x8*)(lds + G_VS + ((rr + 32 * i) * 136 + cc) * 2) = vv[i];
        *(LAS bf16x8*)(lds + G_WS + ((rr + 32 * i) * 136 + cc) * 2) = ww[i];
    }
    {
        float s0 = sp0[0] + sp0[2], q0 = sp0[1] + sp0[3], s1 = sp1[0] + sp1[2], q1 = sp1[1] + sp1[3];
#pragma unroll
        for (int o = 1; o < 8; o <<= 1) { s0 += __shfl_xor(s0, o); q0 += __shfl_xor(q0, o); s1 += __shfl_xor(s1, o); q1 += __shfl_xor(q1, o); }
        if ((tid & 7) == 0) {
            const float m0 = s0 * (1.f / 1024.f), m1 = s1 * (1.f / 1024.f);
            mus[tid >> 3] = m0; rss[tid >> 3] = rsqrtf(fmaxf(q0 * (1.f / 1024.f) - m0 * m0, 0.f) + EPS);
            mus[64 + (tid >> 3)] = m1; rss[64 + (tid >> 3)] = rsqrtf(fmaxf(q1 * (1.f / 1024.f) - m1 * m1, 0.f) + EPS);
        }
    }
    LDS_BARRIER();
#pragma unroll
    for (int dd = 0; dd < 2; ++dd) {
        const int dg = wid + 8 * dd;
        float lw[8], lb[8];
#pragma unroll
        for (int q = 0; q < 2; ++q) {
            const f32x4 a = *(const f32x4*)(p.ln_w + hd * 128 + dg * 8 + q * 4), b = *(const f32x4*)(p.ln_b + hd * 128 + dg * 8 + q * 4);
#pragma unroll
            for (int j = 0; j < 4; ++j) { lw[q * 4 + j] = a[j]; lb[q * 4 + j] = b[j]; }
        }
        const int slot0 = (dg >> 2) * 32 + (dg & 3) * 4;
#pragma unroll
        for (int q = 0; q < 2; ++q) {
            const int s = lane + 64 * q;
            const float mu = mus[s], rs = rss[s];
            float v[8]; unpack8(*(const LAS bf16x8*)(lds + G_VS + (s * 136 + dg * 8) * 2), v);
#pragma unroll
            for (int j = 0; j < 8; ++j) v[j] = (v[j] - mu) * rs * lw[j] + lb[j];
#pragma unroll
            for (int j = 0; j < 8; ++j) vnT[(slot0 + (j >> 2) * 16 + (j & 3)) * 136 + s] = (bf16_t)(cvt_pk_bf16(v[j], 0.f) & 0xffffu);
            if (sample) {
                float* vo = p.out + O_VS + (size_t)(r0 + s - T_PROMPT) * 1024 + hd * 128 + dg * 8;
                *(f32x4*)(vo) = (f32x4){v[0], v[1], v[2], v[3]};
                *(f32x4*)(vo + 4) = (f32x4){v[4], v[5], v[6], v[7]};
            }
        }
    }
    LDS_BARRIER();
    {
        bf16x8 Wf[4];
#pragma unroll
        for (int kk = 0; kk < 4; ++kk) Wf[kk] = *(const LAS bf16x8*)(lds + G_WS + ((wt * 16 + fr) * 136 + (kk < nkk ? kk : 0) * 32 + fq * 8) * 2);
        const float bias = p.gbs[hd * 128 + wt * 16 + fr];
#pragma unroll
        for (int q = 0; q < 4; ++q) {
#pragma unroll
            for (int hf = 0; hf < 2; ++hf) {
                f32x4 acc = (f32x4){0.f, 0.f, 0.f, 0.f};
#pragma unroll
                for (int kk = 0; kk < 4; ++kk) {
                    if (kk < nkk) {
                        const bf16x8 A = *(const LAS bf16x8*)(lds + G_VNT + ((q * 32 + hf * 16 + fr) * 136 + (kk0 + kk) * 32 + fq * 8) * 2);
                        acc = MFMA16(A, Wf[kk], acc);
                    }
                }
                u32x2 w; w.x = cvt_pk_bf16(acc[0] + bias, acc[1] + bias); w.y = cvt_pk_bf16(acc[2] + bias, acc[3] + bias);
                *(LAS u32x2*)(lds + G_VS + ((wid * 16 + fr) * 136 + q * 32 + fq * 8 + hf * 4) * 2) = w;
            }
        }
    }
    LDS_BARRIER();
#pragma unroll
    for (int i = 0; i < 4; ++i) {
        float mv[8], uv[8], gv[8], o[8];
        unpack8(*(const LAS bf16x8*)(lds + G_VS + ((rr + 32 * i) * 136 + cc) * 2), mv);
        unpack8(uu[i], uv); unpack8(gg[i], gv);
#pragma unroll
        for (int j = 0; j < 8; ++j) o[j] = uv[j] * mv[j] * silu_f(gv[j]);
        u32x4 w; w.x = cvt_pk_bf16(o[0], o[1]); w.y = cvt_pk_bf16(o[2], o[3]); w.z = cvt_pk_bf16(o[4], o[5]); w.w = cvt_pk_bf16(o[6], o[7]);
        __hip_atomic_store((unsigned long long*)(hb + (size_t)i * 32 * HS), ((unsigned long long)w.y << 32) | w.x, __ATOMIC_RELAXED, __HIP_MEMORY_SCOPE_AGENT);
        __hip_atomic_store((unsigned long long*)(hb + (size_t)i * 32 * HS + 4), ((unsigned long long)w.w << 32) | w.z, __ATOMIC_RELAXED, __HIP_MEMORY_SCOPE_AGENT);
    }
    if (sample) item_done(p);
    else {
        asm volatile("s_waitcnt vmcnt(0)" ::: "memory");
        __syncthreads();
        const int c128 = item >> 3;
        if (tid == 0) __hip_atomic_fetch_add(p.bar + PCNT_OFF + (c128 >> 5) * 16 + ((c128 & 31) >> 1), 1u, __ATOMIC_RELAXED, __HIP_MEMORY_SCOPE_AGENT);
    }
}

__device__ __forceinline__ void phase2b(const Params& p, LAS unsigned char* lds) {
    LAS int* sItem = (LAS int*)(lds + LDS_ITEM_OFF);
    int nxt = 0;
    if (threadIdx.x == 0) nxt = (int)atomicAdd(p.ctr, 1u);
    for (;;) {
        __syncthreads();
        if (threadIdx.x == 0) *sItem = nxt;
        __syncthreads();
        const int it = *sItem;
        if (it >= 640) break;
        if (threadIdx.x == 0 && it >= 128) nxt = (int)atomicAdd(p.ctr, 1u);
        const int seq = it < 128 ? (it >> 4) : 8 + ((it - 128) >> 4);
        ssd_item(p, lds, seq, it & 15);
        if (threadIdx.x == 0 && it < 128) nxt = (int)atomicAdd(p.ctr, 1u);
    }
    if (threadIdx.x == 0) nxt = (int)atomicAdd(p.ctr + 3, 1u);
    for (;;) {
        __syncthreads();
        if (threadIdx.x == 0) *sItem = nxt;
        __syncthreads();
        const int it = *sItem;
        if (it >= 2176) break;
        if (threadIdx.x == 0) nxt = (int)atomicAdd(p.ctr + 3, 1u);
        gmlp_item(p, lds, it < 128 ? 2048 + it : it - 128);
    }
    for (;;) {
        __syncthreads();
        if (threadIdx.x == 0) *sItem = (int)atomicAdd(p.ctr + 2, 1u);
        __syncthreads();
        const int u = *sItem;
        if (u >= 544) break;
        int pm, pn = u & 3;
        if (u < 32) pm = 128 + (u >> 2);
        else { const int v = u - 32; pm = ((v & 31) >> 2) * 16 + (v >> 5); }
        if (threadIdx.x == 0) {
            unsigned* cnt = u < 32 ? p.ctr + 1 : p.bar + PCNT_OFF + pm;
            const unsigned need = u < 32 ? 640u : 32u;
            unsigned sp = 0;
            while (__hip_atomic_load(cnt, __ATOMIC_RELAXED, __HIP_MEMORY_SCOPE_AGENT) < need) { __builtin_amdgcn_s_sleep(8); if (++sp > (1u << 22)) break; }
            __builtin_amdgcn_fence(__ATOMIC_ACQUIRE, "agent");
            asm volatile("s_waitcnt vmcnt(0)" ::: "memory");
        }
        __syncthreads();
        gemm_phase<2, true, true>(p, lds, pm, pn);
    }
}

__device__ __forceinline__ void phase4(const Params& p, int first_row) {
    const int tid = threadIdx.x, lane = tid & 63, wid = tid >> 6;
    const int G = gridDim.x;
    f32x4 nw[4];
#pragma unroll
    for (int i = 0; i < 4; ++i) nw[i] = *(const f32x4*)(p.norm_f_w + i * 256 + lane * 4);
    constexpr int RP = 1;
    for (int row0 = first_row + blockIdx.x * 8 + wid; row0 < T_ALL; row0 += G * 8 * RP) {
        f32x4 v[RP][4]; f32x4 fv[RP][4];
#pragma unroll
        for (int r = 0; r < RP; ++r) {
            const int row = row0 + r * G * 8;
            if (row < T_ALL) {
                const float* o = p.out + (size_t)row * DM;
                const float* fp = p.fpart + (size_t)row * 16;
#pragma unroll
                for (int i = 0; i < 4; ++i) { v[r][i] = *(const f32x4*)(o + i * 256 + lane * 4); fv[r][i] = *(const f32x4*)(fp + i * 4); }
            }
        }
#pragma unroll
        for (int r = 0; r < RP; ++r) {
            const int row = row0 + r * G * 8;
            if (row < T_ALL) {
                float ss = 0.f;
#pragma unroll
                for (int k = 0; k < 4; ++k) ss += (fv[r][k][0] + fv[r][k][1]) + (fv[r][k][2] + fv[r][k][3]);
                const float rs = rsqrtf(ss * (1.f / 1024.f) + EPS);
                float* o = p.out + (size_t)row * DM;
#pragma unroll
                for (int i = 0; i < 4; ++i) *(f32x4*)(o + i * 256 + lane * 4) = v[r][i] * rs * nw[i];
            }
        }
    }
}


#define XB_TMO      128
#define XB_XCNT(j)  (256  + 64 * (j))
#define XB_XSUB(j)  (1280 + 64 * (j))
#define XB_XGEN(j)  (2304 + 64 * (j))
#define XB_TOP      3328
#define XB_TOPGEN   3392
#define XCD_BAR_WORDS 3456
#define XB_SPIN_CAP (1u << 18)
__device__ __forceinline__ unsigned xb_ld(unsigned* p)              { return __hip_atomic_load(p, __ATOMIC_RELAXED, __HIP_MEMORY_SCOPE_AGENT); }
__device__ __forceinline__ unsigned xb_add(unsigned* p, unsigned v) { return __hip_atomic_fetch_add(p, v, __ATOMIC_RELAXED, __HIP_MEMORY_SCOPE_AGENT); }
__device__ __forceinline__ unsigned xb_xcc_id() { return (unsigned)__builtin_amdgcn_s_getreg((3 << 11) | 20) & 0xFu; }
#define XB_SPIN(cond, bar) do { unsigned _sp = 0; while (cond) { __builtin_amdgcn_s_sleep(1); \
    if ((++_sp & 255u) == 0u) { if (xb_ld(&(bar)[XB_TMO])) break; if (_sp > XB_SPIN_CAP) { atomicAdd(&(bar)[XB_TMO], 1u); break; } } } } while (0)
struct XcdBarrier { unsigned* bar; unsigned x; volatile LAS unsigned* st; };
__device__ __forceinline__ XcdBarrier xcd_barrier_post(unsigned* bar, volatile LAS unsigned* st) {
    XcdBarrier b; b.bar = bar; b.x = xb_xcc_id(); b.st = st;
    if (threadIdx.x == 0) (void)xb_add(&bar[XB_XCNT(b.x)], 1u);
    return b;
}
__device__ __forceinline__ void xcd_barrier_complete(unsigned* bar, unsigned x, unsigned& nloc, unsigned& nx) {
    const unsigned G = gridDim.x * gridDim.y * gridDim.z;
    unsigned sum, cnt, mine, sp = 0u;
    for (;;) {
        sum = 0u; cnt = 0u; mine = 0u;
#pragma unroll
        for (unsigned j = 0; j < 16; ++j) { const unsigned c = xb_ld(&bar[XB_XCNT(j)]); sum += c; cnt += (c > 0u) ? 1u : 0u; mine = (j == x) ? c : mine; }
        if (sum == G) break;
        __builtin_amdgcn_s_sleep(1);
        if ((++sp & 255u) == 0u) { if (xb_ld(&bar[XB_TMO])) break; if (sp > XB_SPIN_CAP) { atomicAdd(&bar[XB_TMO], 1u); break; } }
    }
    nloc = mine > 0u ? mine : 1u; nx = cnt > 0u ? cnt : 1u;
}
__device__ __forceinline__ void xcd_barrier(const XcdBarrier& b) {
    asm volatile("s_waitcnt vmcnt(0)" ::: "memory");
    __syncthreads();
    if (threadIdx.x == 0) {
        unsigned* bar = b.bar;
        __builtin_amdgcn_s_waitcnt(0);
        unsigned nloc = b.st[0], nx = b.st[1];
        if (nloc == 0u) { xcd_barrier_complete(bar, b.x, nloc, nx); b.st[0] = nloc; b.st[1] = nx; }
        const unsigned old = xb_add(&bar[XB_XSUB(b.x)], 1u);
        const unsigned gen = old / nloc;
        if (old + 1u == (gen + 1u) * nloc) {
            __builtin_amdgcn_fence(__ATOMIC_RELEASE, "agent");
            asm volatile("s_waitcnt vmcnt(0)" ::: "memory");
            const unsigned og = xb_add(&bar[XB_TOP], 1u);
            const unsigned tg = og / nx;
            if (og + 1u == (tg + 1u) * nx) xb_add(&bar[XB_TOPGEN], 1u);
            else XB_SPIN(xb_ld(&bar[XB_TOPGEN]) == tg, bar);
            __builtin_amdgcn_fence(__ATOMIC_ACQUIRE, "agent");
            xb_add(&bar[XB_XGEN(b.x)], 1u);
            asm volatile("s_waitcnt vmcnt(0)" ::: "memory");
        } else {
            XB_SPIN(xb_ld(&bar[XB_XGEN(b.x)]) == gen, bar);
            __builtin_amdgcn_fence(__ATOMIC_ACQUIRE, "agent");
            asm volatile("s_waitcnt vmcnt(0)" ::: "memory");
        }
    }
    __syncthreads();
}

#if ONE_LAUNCH
__global__ void __launch_bounds__(512) mega_kernel(Params p) {
    extern __shared__ __attribute__((aligned(16))) unsigned char smem[];
    LAS unsigned char* lds = (LAS unsigned char*)smem;
    volatile LAS unsigned* st = (volatile LAS unsigned*)(lds + LDS_ITEM_OFF + 16);
    if (threadIdx.x == 0) { st[0] = 0u; st[1] = 0u; }
    __syncthreads();
    XcdBarrier xb = xcd_barrier_post(p.bar, st);
    LAS int* sC = (LAS int*)(lds + LDS_ITEM_OFF + 32);
    if (threadIdx.x == 0) sC[0] = (int)__hip_atomic_fetch_add(p.ctr + 16 + (xb.x & 7u), 1u, __ATOMIC_RELAXED, __HIP_MEMORY_SCOPE_AGENT);
#if DIAG
    unsigned long long* ts = (unsigned long long*)(p.ctr + 64);
#define STAMP(i) do { if (blockIdx.x == 0 && threadIdx.x == 0) ts[i] = __builtin_amdgcn_s_memrealtime(); } while (0)
    xcd_barrier(xb);
#else
#define STAMP(i) do { } while (0)
#endif
    STAMP(0);
    phase0(p, lds); xcd_barrier(xb); STAMP(1);
    if (threadIdx.x == 0) {
        bool ok = (gridDim.x & 7u) == 0u;
#pragma unroll
        for (int j = 0; j < 8; ++j) ok = ok && __hip_atomic_load(p.ctr + 16 + j, __ATOMIC_RELAXED, __HIP_MEMORY_SCOPE_AGENT) == gridDim.x / 8u;
        sC[1] = ok ? sC[0] * 8 + (int)(xb.x & 7u) : (int)blockIdx.x;
    }
    __syncthreads();
    { const int cperm = sC[1]; gemm_phase<1>(p, lds, 0, 0, cperm); phase1_tail(p, lds, cperm); } xcd_barrier(xb); STAMP(2);
    phase2a(p, lds); xcd_barrier(xb); STAMP(3);
    phase2b(p, lds);
#if DIAG
    xcd_barrier(xb); STAMP(4);
    xcd_barrier(xb);
    {
#if DIAG == 3
        float ta = (float)p.ctr[40] * 0.0001f, tb = (float)p.ctr[41] * 0.01f * 5.f;
#elif DIAG == 2
        float ta = (float)p.ctr[36] * 0.01f / 128.f, tb = (float)p.ctr[37] * 0.01f / 2176.f;
        ta = exp2f(rintf(log2f(ta) * 12.f) / 12.f); tb = exp2f(rintf(log2f(tb) * 12.f) / 12.f) * 30.f;
#else
        float ta = (float)(ts[DIAG_A + 1] - ts[DIAG_A]) * 0.01f, tb = (float)(ts[DIAG_B + 1] - ts[DIAG_B]) * 0.01f;
        ta *= 0.01f;
#endif
        if (blockIdx.x == 0 && threadIdx.x == 0) p.out[0] += ta;
        for (int i = blockIdx.x * 512 + threadIdx.x; i < 2097152; i += gridDim.x * 512) p.out[O_VS + i] += tb * 0.001f;
    }
#endif
}
#else
template <int PH> __global__ void __launch_bounds__(512) phase_kernel(Params p) {
    extern __shared__ __attribute__((aligned(16))) unsigned char smem[];
    LAS unsigned char* lds = (LAS unsigned char*)smem;
    if (PH == 0) phase0(p, lds);
    if (PH == 1) gemm_phase<1>(p, lds);
    if (PH == 2) phase2a(p, lds);
    if (PH == 3) phase2b(p, lds);
    if (PH == 4) gemm_phase<2, false, false>(p, lds);
    if (PH == 5) phase4(p, 0);
}
#endif

extern "C" void kernel_launch(void* const* d_in, const int* in_sizes, int n_in, void* d_out, int out_size, void* d_ws, size_t ws_size, hipStream_t stream) {
    static int grid = 0;
    if (grid == 0) {
        if (n_in != 18 || ws_size < WS_END) { fprintf(stderr, "kernel_launch: need 18 inputs and >= %zu bytes of workspace (got %d, %zu)\n", (size_t)WS_END, n_in, ws_size); grid = -1; return; }
        int dev = 0, cus = 0, per_cu = 0;
        hipGetDevice(&dev);
        hipDeviceGetAttribute(&cus, hipDeviceAttributeMultiprocessorCount, dev);
#if ONE_LAUNCH
        hipFuncSetAttribute((const void*)mega_kernel, hipFuncAttributeMaxDynamicSharedMemorySize, LDS_BYTES);
        hipOccupancyMaxActiveBlocksPerMultiprocessor(&per_cu, (const void*)mega_kernel, 512, LDS_BYTES);
        if (per_cu < 1) { fprintf(stderr, "kernel_launch: occupancy query says %d blocks per CU\n", per_cu); per_cu = 1; }
        grid = cus * per_cu;
#else
        hipFuncSetAttribute((const void*)phase_kernel<0>, hipFuncAttributeMaxDynamicSharedMemorySize, LDS_BYTES);
        hipFuncSetAttribute((const void*)phase_kernel<1>, hipFuncAttributeMaxDynamicSharedMemorySize, LDS_BYTES);
        hipFuncSetAttribute((const void*)phase_kernel<2>, hipFuncAttributeMaxDynamicSharedMemorySize, LDS_BYTES);
        hipFuncSetAttribute((const void*)phase_kernel<3>, hipFuncAttributeMaxDynamicSharedMemorySize, LDS_BYTES);
        hipFuncSetAttribute((const void*)phase_kernel<4>, hipFuncAttributeMaxDynamicSharedMemorySize, LDS_BYTES);
        hipFuncSetAttribute((const void*)phase_kernel<5>, hipFuncAttributeMaxDynamicSharedMemorySize, LDS_BYTES);
        (void)per_cu;
        grid = cus;
#endif
    }
    if (grid < 0) return;
    Params p{};
    p.x_prompt = (const float*)d_in[0]; p.x_sample = (const float*)d_in[1]; p.state_ssm = (const float*)d_in[2]; p.state_conv = (const float*)d_in[3];
    p.norm_in_w = (const float*)d_in[4]; p.w_in = (const float*)d_in[5]; p.ln_w = (const float*)d_in[6]; p.ln_b = (const float*)d_in[7];
    p.gws = (const float*)d_in[8]; p.gbs = (const float*)d_in[9]; p.conv_w = (const float*)d_in[10]; p.conv_b = (const float*)d_in[11];
    p.dt_bias = (const float*)d_in[12]; p.a_log = (const float*)d_in[13]; p.d_skip = (const float*)d_in[14]; p.ssm_norm_w = (const float*)d_in[15];
    p.w_out = (const float*)d_in[16]; p.norm_f_w = (const float*)d_in[17];
    p.out = (float*)d_out;
    unsigned char* ws = (unsigned char*)d_ws;
    p.h = (bf16_t*)(ws + WS_H); p.xn = (bf16_t*)(ws + WS_XN); p.WinT = (bf16_t*)(ws + WS_WINT); p.WoutT = (bf16_t*)(ws + WS_WOUTT);
    p.WdtT = (bf16_t*)(ws + WS_WDTT); p.Wm = (bf16_t*)(ws + WS_WM); p.BT = (bf16_t*)(ws + WS_BT);
    p.xbc = (bf16_t*)d_out;
    p.stats = (float*)(ws + WS_STATS); p.ssq = (float*)(ws + WS_SSQ); p.fpart = (float*)(ws + WS_FPART);
    p.dtT = (float*)(ws + WS_DTT); p.acT = (float*)(ws + WS_ACT); p.ctr = (unsigned*)(ws + WS_CTR); p.bar = (unsigned*)(ws + WS_BAR); p.dtraw = (float*)(ws + WS_DTRAW);
#if ONE_LAUNCH
    if (hipMemsetAsync(ws + WS_CTR, 0, 1024 + 16384, stream) != hipSuccess) { fprintf(stderr, "kernel_launch: memset of barrier words failed\n"); return; }
    void* args[] = {&p};
    hipError_t e = hipLaunchCooperativeKernel((const void*)mega_kernel, dim3(grid), dim3(512), args, LDS_BYTES, stream);
    if (e != hipSuccess) fprintf(stderr, "cooperative launch failed: %s (grid %d)\n", hipGetErrorString(e), grid);
#else
    hipLaunchKernelGGL(phase_kernel<0>, dim3(grid), dim3(512), LDS_BYTES, stream, p);
    hipLaunchKernelGGL(phase_kernel<1>, dim3(grid), dim3(512), LDS_BYTES, stream, p);
    hipLaunchKernelGGL(phase_kernel<2>, dim3(grid), dim3(512), LDS_BYTES, stream, p);
    hipLaunchKernelGGL(phase_kernel<3>, dim3(grid), dim3(512), LDS_BYTES, stream, p);
    hipLaunchKernelGGL(phase_kernel<4>, dim3(grid), dim3(512), LDS_BYTES, stream, p);
    hipLaunchKernelGGL(phase_kernel<5>, dim3(grid), dim3(512), LDS_BYTES, stream, p);
#endif
}
```
